# Optimizing an MI355X kernel written in HIP

```python
import math
import jax, jax.numpy as jnp
from jax import lax
import numpy as np

D_MODEL = 2048
BATCH = 8
SEQ = 2048
DEPTH = 4
DEC_BATCH = 4
DEC_SEQ = 4096
PAST_LEN = 128

GRID_W = 64
N_MIXERS = 2
N_ATTN_LAYERS = (DEPTH + 1) // 2
N_MLSTM_LAYERS = DEPTH // 2
HEAD_DIM = 128
N_Q_HEADS = D_MODEL // HEAD_DIM
N_KV_HEADS = N_Q_HEADS // 4
Q_BLOCK = 128
ROPE_THETA = 10000.0
ATTN_IN = (N_Q_HEADS + 2 * N_KV_HEADS) * HEAD_DIM
ML_HEADS = 8
ML_DV = D_MODEL // ML_HEADS
ML_DQK = ML_DV // 2
ML_CHUNK = 64
ML_GATES = 4 * ML_HEADS
ML_IN = 2 * ML_HEADS * ML_DQK + 2 * D_MODEL + ML_GATES
MEM_LEN = 256
XA_HEADS = 4
XA_HEAD_DIM = D_MODEL // XA_HEADS
D_FF = 4 * D_MODEL
DN_ALPHA = (2 * DEPTH) ** 0.25
DN_BETA = (8 * DEPTH) ** -0.25
LN_EPS = 1e-5
RMS_EPS = 1e-6

kernel_name = "hybrid_gqa_mlstm_deepnorm_encoder"

F32 = jnp.float32


def _layer_norm(x, g, b):
    xf = x.astype(F32)
    mu = xf.mean(-1, keepdims=True)
    var = jnp.square(xf - mu).mean(-1, keepdims=True)
    return ((xf - mu) * lax.rsqrt(var + LN_EPS) * g.astype(F32) + b.astype(F32)).astype(x.dtype)


def _rms_norm(x, g):
    xf = x.astype(F32)
    return (xf * lax.rsqrt(jnp.mean(xf * xf, -1, keepdims=True) + RMS_EPS) * g.astype(F32)).astype(x.dtype)


def _axial_rope_tables(S):
    rows = S // GRID_W
    row_ids = jnp.repeat(jnp.arange(rows), GRID_W).astype(F32)
    col_ids = jnp.tile(jnp.arange(GRID_W), rows).astype(F32)
    axis_dim = HEAD_DIM // 2
    inv_freq = ROPE_THETA ** (-jnp.arange(0, axis_dim, 2, dtype=F32) / axis_dim)
    ang = jnp.stack([row_ids[:, None] * inv_freq, col_ids[:, None] * inv_freq], axis=1)
    return jnp.cos(ang), jnp.sin(ang)


def _apply_axial_rope(x, cos, sin):
    B, S, H, _ = x.shape
    xs = x.astype(F32).reshape(B, S, H, 2, 2, HEAD_DIM // 4)
    x1, x2 = xs[..., 0, :], xs[..., 1, :]
    c, s = cos[:, None], sin[:, None]
    out = jnp.stack([x1 * c - x2 * s, x1 * s + x2 * c], axis=-2)
    return out.reshape(B, S, H, HEAD_DIM).astype(x.dtype)


def _gqa_axial(x, w_in, q_gain, k_gain, w_out):
    B, S, _ = x.shape
    h = x @ w_in
    q, k, v = jnp.split(h, [N_Q_HEADS * HEAD_DIM, (N_Q_HEADS + N_KV_HEADS) * HEAD_DIM], axis=-1)
    q = q.reshape(B, S, N_Q_HEADS, HEAD_DIM)
    k = k.reshape(B, S, N_KV_HEADS, HEAD_DIM)
    v = v.reshape(B, S, N_KV_HEADS, HEAD_DIM)
    cos, sin = _axial_rope_tables(S)
    q = _apply_axial_rope(_rms_norm(q, q_gain), cos, sin)
    k = _apply_axial_rope(_rms_norm(k, k_gain), cos, sin)
    G = N_Q_HEADS // N_KV_HEADS
    q = q.transpose(0, 2, 1, 3).reshape(B, N_KV_HEADS, G, S, HEAD_DIM)
    k = k.transpose(0, 2, 1, 3)
    v = v.transpose(0, 2, 1, 3)
    nb = S // Q_BLOCK
    qb = jnp.moveaxis(q.reshape(B, N_KV_HEADS, G, nb, Q_BLOCK, HEAD_DIM), 3, 0)
    scale = HEAD_DIM ** -0.5

    def block(qblk):
        s = jnp.einsum('bkgqd,bksd->bkgqs', qblk, k, preferred_element_type=F32) * scale
        p = jax.nn.softmax(s, axis=-1).astype(v.dtype)
        return jnp.einsum('bkgqs,bksd->bkgqd', p, v)

    o = lax.map(block, qb)
    o = jnp.moveaxis(o, 0, 3).reshape(B, N_Q_HEADS, S, HEAD_DIM)
    o = o.transpose(0, 2, 1, 3).reshape(B, S, N_Q_HEADS * HEAD_DIM)
    return o @ w_out


def _mlstm_chunkwise(q, k, v, log_i, log_f):
    B, H, S, DK = q.shape
    DV = v.shape[-1]
    nc = S // ML_CHUNK

    def chunks(a):
        a = a.reshape(B, H, nc, ML_CHUNK, *a.shape[3:])
        return jnp.moveaxis(a, 2, 0)

    xs = tuple(chunks(a) for a in (q, k, v, log_i, log_f))
    lower = jnp.tril(jnp.ones((ML_CHUNK, ML_CHUNK), dtype=bool))

    def step(carry, inp):
        C, n, m = carry
        qj, kj, vj, ij, fj = inp
        b = jnp.cumsum(fj, axis=-1)
        d = b[..., :, None] - b[..., None, :] + ij[..., None, :]
        d = jnp.where(lower, d, -jnp.inf)
        inter = b + m[..., None]
        m_j = jnp.maximum(inter, d.max(-1))
        w = jnp.exp(d - m_j[..., None])
        g = jnp.exp(inter - m_j)
        s = jnp.einsum('bhld,bhsd->bhls', qj, kj) * w
        num = g[..., None] * jnp.einsum('bhvd,bhld->bhlv', C, qj) + jnp.einsum('bhls,bhsv->bhlv', s, vj)
        den = g * jnp.einsum('bhd,bhld->bhl', n, qj) + s.sum(-1)
        h = num / jnp.maximum(jnp.abs(den), jnp.exp(-m_j))[..., None]
        bL = b[..., -1]
        dl = bL[..., None] - b + ij
        m_new = jnp.maximum(bL + m, dl.max(-1))
        gs = jnp.exp(bL + m - m_new)
        ws = jnp.exp(dl - m_new[..., None])
        C = gs[..., None, None] * C + jnp.einsum('bhs,bhsv,bhsd->bhvd', ws, vj, kj)
        n = gs[..., None] * n + jnp.einsum('bhs,bhsd->bhd', ws, kj)
        return (C, n, m_new), h

    init = (jnp.zeros((B, H, DV, DK), F32), jnp.zeros((B, H, DK), F32), jnp.zeros((B, H), F32))
    _, hs = lax.scan(step, init, xs)
    return jnp.moveaxis(hs, 0, 2).reshape(B, H, S, DV)


def _mlstm_bidir(x, w_in, b_gate, head_gain, w_out):
    B, S, _ = x.shape
    h = x @ w_in
    nqk = ML_HEADS * ML_DQK
    q, k, v, o, gates = jnp.split(h, [nqk, 2 * nqk, 2 * nqk + D_MODEL, 2 * nqk + 2 * D_MODEL], axis=-1)

    def to_heads(a, d):
        return a.reshape(B, S, ML_HEADS, d).transpose(0, 2, 1, 3).astype(F32)

    q = to_heads(q, ML_DQK)
    k = to_heads(k, ML_DQK) * (ML_DQK ** -0.5)
    v = to_heads(v, ML_DV)
    gates = (gates.reshape(B, S, 4, ML_HEADS) + b_gate).astype(F32).transpose(2, 0, 3, 1)
    log_i_f, log_f_f = gates[0], jax.nn.log_sigmoid(gates[1])
    log_i_b, log_f_b = gates[2], jax.nn.log_sigmoid(gates[3])
    h_f = _mlstm_chunkwise(q, k, v, log_i_f, log_f_f)

    def flip(a):
        return jnp.flip(a, axis=2)

    h_b = flip(_mlstm_chunkwise(flip(q), flip(k), flip(v), flip(log_i_b), flip(log_f_b)))
    hs = (h_f + h_b).transpose(0, 2, 1, 3)
    hs = _rms_norm(hs, head_gain).reshape(B, S, D_MODEL)
    hs = hs * jax.nn.sigmoid(o.astype(F32))
    return hs.astype(x.dtype) @ w_out


def _mem_cross_attn(x, mem, w_q, w_kv, w_out):
    B, S, _ = x.shape
    M = mem.shape[1]
    q = (x @ w_q).reshape(B, S, XA_HEADS, XA_HEAD_DIM)
    kv = (mem @ w_kv).reshape(B, M, 2, XA_HEADS, XA_HEAD_DIM)
    s = jnp.einsum('bshd,bmhd->bhsm', q, kv[:, :, 0], preferred_element_type=F32) * (XA_HEAD_DIM ** -0.5)
    p = jax.nn.softmax(s, axis=-1).astype(x.dtype)
    o = jnp.einsum('bhsm,bmhd->bshd', p, kv[:, :, 1]).reshape(B, S, D_MODEL)
    return o @ w_out


def _sq_relu_mlp(x, w1, w2):
    return jnp.square(jax.nn.relu(x @ w1)) @ w2


def _trunk(x, mem, p):
    for i in range(DEPTH):
        j = i // N_MIXERS
        if i % N_MIXERS == 0:
            y = _gqa_axial(x, p['attn_w_in'][j], p['attn_q_gain'][j], p['attn_k_gain'][j], p['attn_w_out'][j])
        else:
            y = _mlstm_bidir(x, p['ml_w_in'][j], p['ml_b_gate'][j], p['ml_head_gain'][j], p['ml_w_out'][j])
        x = _layer_norm(DN_ALPHA * x + y, p['ln_g'][i, 0], p['ln_b'][i, 0])
        y = _mem_cross_attn(x, mem, p['xa_w_q'][i], p['xa_w_kv'][i], p['xa_w_out'][i])
        x = _layer_norm(DN_ALPHA * x + y, p['ln_g'][i, 1], p['ln_b'][i, 1])
        y = _sq_relu_mlp(x, p['mlp_w1'][i], p['mlp_w2'][i])
        x = _layer_norm(DN_ALPHA * x + y, p['ln_g'][i, 2], p['ln_b'][i, 2])
    return x


def _normal(key, shape, scale):
    return jax.random.normal(key, shape, F32) * scale


def setup_inputs(seed: int = 0) -> dict:
    key = jax.random.key(seed)
    ks = jax.random.split(key, 19)
    D = D_MODEL
    gate_base = jnp.array([0.0, 3.0, 0.0, 3.0], F32)[None, :, None]
    return {
        'x_prompt': _normal(ks[0], (BATCH, SEQ, D), 1.0),
        'x_sample': _normal(ks[1], (DEC_BATCH, DEC_SEQ, D), 1.0),
        'mem_prompt': _normal(ks[2], (BATCH, MEM_LEN, D), 1.0),
        'mem_sample': _normal(ks[3], (DEC_BATCH, MEM_LEN, D), 1.0),
        'attn_w_in': _normal(ks[4], (N_ATTN_LAYERS, D, ATTN_IN), D ** -0.5),
        'attn_q_gain': 1.0 + _normal(ks[5], (N_ATTN_LAYERS, HEAD_DIM), 0.02),
        'attn_k_gain': 1.0 + _normal(ks[6], (N_ATTN_LAYERS, HEAD_DIM), 0.02),
        'attn_w_out': _normal(ks[7], (N_ATTN_LAYERS, N_Q_HEADS * HEAD_DIM, D), DN_BETA * (N_Q_HEADS * HEAD_DIM) ** -0.5),
        'ml_w_in': _normal(ks[8], (N_MLSTM_LAYERS, D, ML_IN), D ** -0.5),
        'ml_b_gate': gate_base + _normal(ks[9], (N_MLSTM_LAYERS, 4, ML_HEADS), 0.1),
        'ml_head_gain': 1.0 + _normal(ks[10], (N_MLSTM_LAYERS, ML_HEADS, ML_DV), 0.02),
        'ml_w_out': _normal(ks[11], (N_MLSTM_LAYERS, D, D), DN_BETA * D ** -0.5),
        'xa_w_q': _normal(ks[12], (DEPTH, D, D), D ** -0.5),
        'xa_w_kv': _normal(ks[13], (DEPTH, D, 2 * D), D ** -0.5),
        'xa_w_out': _normal(ks[14], (DEPTH, D, D), DN_BETA * D ** -0.5),
        'mlp_w1': _normal(ks[15], (DEPTH, D, D_FF), D ** -0.5),
        'mlp_w2': _normal(ks[16], (DEPTH, D_FF, D), DN_BETA * D_FF ** -0.5),
        'ln_g': 1.0 + _normal(ks[17], (DEPTH, 3, D), 0.02),
        'ln_b': _normal(ks[18], (DEPTH, 3, D), 0.02),
    }


def reference(x_prompt, x_sample, mem_prompt, mem_sample, attn_w_in, attn_q_gain, attn_k_gain, attn_w_out,
              ml_w_in, ml_b_gate, ml_head_gain, ml_w_out, xa_w_q, xa_w_kv, xa_w_out, mlp_w1, mlp_w2,
              ln_g, ln_b):
    params = {
        'attn_w_in': attn_w_in, 'attn_q_gain': attn_q_gain, 'attn_k_gain': attn_k_gain,
        'attn_w_out': attn_w_out, 'ml_w_in': ml_w_in, 'ml_b_gate': ml_b_gate,
        'ml_head_gain': ml_head_gain, 'ml_w_out': ml_w_out, 'xa_w_q': xa_w_q, 'xa_w_kv': xa_w_kv,
        'xa_w_out': xa_w_out, 'mlp_w1': mlp_w1, 'mlp_w2': mlp_w2, 'ln_g': ln_g, 'ln_b': ln_b,
    }
    y_prompt = _trunk(x_prompt, mem_prompt, params)
    y_sample = _trunk(x_sample, mem_sample, params)
    return (y_prompt, y_sample)
```

```cpp
#include <hip/hip_runtime.h>
#include <cstdio>
#include <cstdint>

#ifndef PROBE_MASK
#define PROBE_MASK 0
#endif
#ifndef PG_ALIGN
#define PG_ALIGN true
#endif
#ifndef PG_SP2
#define PG_SP2 true
#endif
#ifndef MK_ONE_LAUNCH
#define MK_ONE_LAUNCH 1
#endif

#define LAS __attribute__((address_space(3)))
typedef unsigned short bf16_t;
typedef short bf16x8 __attribute__((ext_vector_type(8)));
typedef short s16x4 __attribute__((ext_vector_type(4)));
typedef float f32x2 __attribute__((ext_vector_type(2)));
typedef float f32x4 __attribute__((ext_vector_type(4)));
typedef float f32x16 __attribute__((ext_vector_type(16)));
typedef unsigned u32x2 __attribute__((ext_vector_type(2)));
typedef unsigned u32x4 __attribute__((ext_vector_type(4)));

constexpr int DM = 2048, NTOK = 32768, NPR = 16384;
constexpr int MEMROWS = 3072;
constexpr int ATT_IN = 3072, ML_MAIN = 6144, ML_IN = 6176, DFF = 8192;
constexpr float DN_ALPHA = 1.681792830507429f, LN_EPS = 1e-5f, RMS_EPS = 1e-6f;
constexpr int NWAVES = 8, NTHR = 512;

constexpr size_t MiB = 1u << 20;
constexpr size_t WS_CTL = 0, CTL_ZERO_BYTES = 64 * 1024;
constexpr size_t WS_ROPE = 1 * MiB;
constexpr size_t WS_ZERO = WS_ROPE + 64 * 1024;
constexpr size_t WS_ONE = WS_ZERO + 32 * 1024;
constexpr size_t WS_RSID = WS_ONE + 8 * 1024;
constexpr size_t WS_C1 = WS_ROPE + 256 * 1024;
constexpr size_t WS_C2 = WS_C1 + 256 * 1024;
constexpr size_t WS_C1S = WS_C2 + 256 * 1024, WS_C2S = WS_C1S + 64 * 1024;
constexpr size_t WS_RS = 2 * MiB;
constexpr size_t WS_GATES = 3 * MiB;
constexpr size_t WS_P = 8 * MiB;
constexpr size_t WS_W = 16 * MiB;
constexpr size_t W_ATT_IN = WS_W;
constexpr size_t W_ATT_OUT = W_ATT_IN + 24 * MiB;
constexpr size_t W_ML_IN = W_ATT_OUT + 16 * MiB;
constexpr size_t W_ML_OUT = W_ML_IN + 50 * MiB;
constexpr size_t W_XA_Q = W_ML_OUT + 16 * MiB;
constexpr size_t W_XA_OUT = W_XA_Q + 32 * MiB;
constexpr size_t W_W1 = W_XA_OUT + 32 * MiB;
constexpr size_t W_W2 = W_W1 + 128 * MiB;
constexpr size_t WS_KMEM = W_W2 + 128 * MiB;
constexpr size_t WS_VT = WS_KMEM + 48 * MiB;
constexpr size_t WS_ZB = WS_VT + 48 * MiB;
constexpr size_t WS_S = WS_ZB + 128 * MiB;
constexpr size_t S_WKT = WS_S, S_WVT = WS_S + 32 * MiB, S_MEMB = WS_S + 64 * MiB, S_CPART = WS_S + 80 * MiB;
constexpr size_t S_QKV = WS_S, S_OB = WS_S + 192 * MiB;
constexpr size_t S_H = WS_S, S_HF = WS_S + 192 * MiB, S_HB = WS_S + 320 * MiB, S_HSB = WS_S + 448 * MiB;
constexpr size_t S_QX = WS_S, S_SC = WS_S + 128 * MiB, S_PB = WS_S + 256 * MiB, S_OX = WS_S + 320 * MiB;
constexpr size_t S_HID = WS_S;
constexpr size_t WS_END = WS_S + 576 * MiB;
constexpr int CV_ATT_IN = 0, CV_ML_IN = 3072, CV_XAQ = 3072 + 2 * 6176, CV_W1 = CV_XAQ + 4 * 2048, CV_END = CV_W1 + 4 * 8192;

constexpr int LDS_BYTES = 155648, LDS_MISC = 131072, LDS_XL = 131072 + 4096, LDS_PAR = 147456;

__device__ __forceinline__ unsigned f2bf(float f) { unsigned u = __float_as_uint(f); return (u + 0x7fffu + ((u >> 16) & 1u)) >> 16; }
__device__ __forceinline__ float bf2f(unsigned b) { return __uint_as_float(b << 16); }
__device__ __forceinline__ unsigned pk2(float lo, float hi) { return f2bf(lo) | (f2bf(hi) << 16); }
typedef __bf16 bf16x2_t __attribute__((ext_vector_type(2)));
__device__ __forceinline__ unsigned cvt_pk_bf16(float lo, float hi) { f32x2 v = {lo, hi}; bf16x2_t b = __builtin_convertvector(v, bf16x2_t); return __builtin_bit_cast(unsigned, b); }
__device__ __forceinline__ float sum_x16(float v) { auto r = __builtin_amdgcn_permlane16_swap(__float_as_uint(v), __float_as_uint(v), false, false); return __uint_as_float(r[0]) + __uint_as_float(r[1]); }
__device__ __forceinline__ float sum_x32(float v) { auto r = __builtin_amdgcn_permlane32_swap(__float_as_uint(v), __float_as_uint(v), false, false); return __uint_as_float(r[0]) + __uint_as_float(r[1]); }
__device__ __forceinline__ float max_x16(float v) { auto r = __builtin_amdgcn_permlane16_swap(__float_as_uint(v), __float_as_uint(v), false, false); return fmaxf(__uint_as_float(r[0]), __uint_as_float(r[1])); }
__device__ __forceinline__ float max_x32(float v) { auto r = __builtin_amdgcn_permlane32_swap(__float_as_uint(v), __float_as_uint(v), false, false); return fmaxf(__uint_as_float(r[0]), __uint_as_float(r[1])); }
#define DPPF(old, v, ctrl, rmask) __int_as_float(__builtin_amdgcn_update_dpp(__float_as_int(old), __float_as_int(v), (ctrl), (rmask), 0xf, false))
__device__ __forceinline__ float sum8(float v) { v += DPPF(0.f, v, 0xB1, 0xf); v += DPPF(0.f, v, 0x4E, 0xf); v += DPPF(0.f, v, 0x141, 0xf); return v; }
__device__ __forceinline__ float scan_add(float v) { v += DPPF(0.f, v, 0x111, 0xf); v += DPPF(0.f, v, 0x112, 0xf); v += DPPF(0.f, v, 0x114, 0xf); v += DPPF(0.f, v, 0x118, 0xf);
    v += DPPF(0.f, v, 0x142, 0xa); v += DPPF(0.f, v, 0x143, 0xc); return v; }
__device__ __forceinline__ float scan_max(float v) { const float ninf = -3.0e38f; v = fmaxf(v, DPPF(ninf, v, 0x111, 0xf)); v = fmaxf(v, DPPF(ninf, v, 0x112, 0xf)); v = fmaxf(v, DPPF(ninf, v, 0x114, 0xf)); v = fmaxf(v, DPPF(ninf, v, 0x118, 0xf));
    v = fmaxf(v, DPPF(ninf, v, 0x142, 0xa)); v = fmaxf(v, DPPF(ninf, v, 0x143, 0xc)); return v; }
__device__ __forceinline__ float wave_sum(float v) { v += DPPF(0.f, v, 0xB1, 0xf); v += DPPF(0.f, v, 0x4E, 0xf); v += DPPF(0.f, v, 0x141, 0xf); v += DPPF(0.f, v, 0x140, 0xf); return sum_x32(sum_x16(v)); }
__device__ __forceinline__ float wave_max(float v) { v = fmaxf(v, DPPF(v, v, 0xB1, 0xf)); v = fmaxf(v, DPPF(v, v, 0x4E, 0xf)); v = fmaxf(v, DPPF(v, v, 0x141, 0xf)); v = fmaxf(v, DPPF(v, v, 0x140, 0xf)); return max_x32(max_x16(v)); }
#define LDS_WAIT() asm volatile("s_waitcnt lgkmcnt(0)" ::: "memory")
__device__ __forceinline__ int opaque_tid() { int t = threadIdx.x; asm volatile("" : "+v"(t)); return t; }

__host__ __device__ __forceinline__ size_t tile_off(int r, int c, int ld) { return ((size_t)(r >> 4) * (ld >> 5) + (c >> 5)) * 512 + (r & 15) * 32 + (c & 31); }
namespace pg8 {
constexpr int BM = 256, BK = 64, HALF = 128, HTB = HALF * BK * 2, STAGE_BYTES = 8 * HTB, NXCD = 8, WGM = 4;
__host__ __device__ __forceinline__ int lds_byte(int r, int c) { const int st = (r >> 4) * 2 + (c >> 5), rr = r & 15, cc = c & 31, ob = rr * 64 + cc * 2; return st * 1024 + (ob ^ (((ob >> 9) & 1) << 5)); }
__host__ __device__ __forceinline__ void stage_rc(int b, int& R, int& C) { const int st = b / 1024, sb = b % 1024, swz = sb ^ (((sb >> 9) & 1) << 5); R = (st >> 1) * 16 + swz / 64; C = (st & 1) * 32 + (swz % 64) / 2; }
__host__ __device__ __forceinline__ int perm32(int rho) { const int n = rho >> 4, i = rho & 15; return 8 * (i >> 2) + 4 * n + (i & 3); }

struct Unit { int pm, pn; const char* a; const char* b; };
struct Gemm { int lda, ldb, K; };

struct PlainOrder {
    int nM, nN, nwg, G, c; const char* A; const char* B; size_t tA, tB; int rev = 0;
    __device__ __forceinline__ void init(int M, int N, int G_, int c_, const void* A_, int lda, const void* B_, int ldb) {
        nM = M / BM; nN = N / BM; nwg = nM * nN; G = G_; c = c_; A = (const char*)A_; B = (const char*)B_; tA = (size_t)BM * lda * 2; tB = (size_t)BM * ldb * 2; }
    __device__ __forceinline__ bool next(int i, Unit& u) const {
        long L = (long)i * G + c; if (L >= nwg) return false;
        if (rev) { const int nr = (nwg + G - 1) / G; L = (long)(nr - 1 - i) * G + c; if (L >= nwg) return false; }
        int wgid = (int)L; { const int q = nwg / NXCD, r = nwg % NXCD, xcd = wgid % NXCD, off = wgid / NXCD; wgid = (xcd < r ? xcd * (q + 1) : r * (q + 1) + (xcd - r) * q) + off; }
        const int nig = WGM * nN, gid = wgid / nig, fm = gid * WGM, gsz = (nM - fm) < WGM ? (nM - fm) : WGM;
        u.pm = fm + ((wgid % nig) % gsz); u.pn = (wgid % nig) / gsz; u.a = A + (size_t)u.pm * tA; u.b = B + (size_t)u.pn * tB; return true;
    }
};

template <class Epi, class Sched, bool ALIGN_EPI, bool SP2, bool ATILE = false>
__device__ __forceinline__ void gemm_phase(LAS unsigned char* lds, const Gemm g, const Sched& S, const Epi& E) {
    const int tid = opaque_tid(), wid = __builtin_amdgcn_readfirstlane(tid >> 6), lane = tid & 63, wr = wid >> 2, wc = wid & 3, fr = lane & 15, fq = lane >> 4;
    const int K = g.K, nt = K / BK;
    unsigned voffA[2], voffB[2];
#pragma unroll
    for (int i = 0; i < 2; ++i) { int R, C; stage_rc(tid * 16 + i * 8192, R, C); const int Rb = Epi::PERM ? ((R & ~31) + perm32(R & 31)) : R;
        voffA[i] = ATILE ? (unsigned)(((R >> 4) * (g.lda >> 5) + (C >> 5)) * 512 + (R & 15) * 32 + (C & 31)) * 2u : (unsigned)(R * g.lda + C) * 2u; voffB[i] = (unsigned)(Rb * g.ldb + C) * 2u; }
    const size_t kstep = (size_t)(BK * 2), kstepA = ATILE ? (size_t)2048 : kstep;
    const size_t hA = (size_t)HALF * g.lda * 2, hB = (size_t)HALF * g.ldb * 2;
    const unsigned ldsw = (unsigned)wid * 1024u;
    const int aoff = lds_byte(wr * 64 + fr, fq * 8), boff = lds_byte(wc * 32 + fr, fq * 8);
#define PG8_SA(b, h) (((b) * 2 + (h)) * HTB)
#define PG8_SB(b, h) ((4 + (b) * 2 + (h)) * HTB)
#define PG8_STAGE(bufoff, gbase, voff) do { _Pragma("unroll") for (int _i = 0; _i < 2; ++_i) \
        __builtin_amdgcn_global_load_lds((const unsigned*)((const char*)(gbase) + (voff)[_i]), (LAS unsigned*)(lds + (bufoff) + ldsw + _i * 8192), 16, 0, 0); } while (0)
#define PG8_LDA(dst, b, h) do { _Pragma("unroll") for (int m = 0; m < 4; ++m) _Pragma("unroll") for (int k = 0; k < 2; ++k) dst[m][k] = *(const LAS bf16x8*)(lds + PG8_SA(b, h) + aoff + m * 2048 + k * 1024); } while (0)
#define PG8_LDB(dst, b, h) do { _Pragma("unroll") for (int n = 0; n < 2; ++n) _Pragma("unroll") for (int k = 0; k < 2; ++k) dst[n][k] = *(const LAS bf16x8*)(lds + PG8_SB(b, h) + boff + n * 2048 + k * 1024); } while (0)
#define PG8_MMA(ai, bj, At, Bt) do { __builtin_amdgcn_s_setprio(1); _Pragma("unroll") for (int m = 0; m < 4; ++m) _Pragma("unroll") for (int n = 0; n < 2; ++n) _Pragma("unroll") for (int k = 0; k < 2; ++k) \
        acc[ai][bj][m][n] = __builtin_amdgcn_mfma_f32_16x16x32_bf16(Bt[n][k], At[m][k], acc[ai][bj][m][n], 0, 0, 0); __builtin_amdgcn_s_setprio(0); } while (0)
#define PG8_WAIT_V(n) asm volatile("s_waitcnt vmcnt(" #n ")" ::: "memory")
#define PG8_WAIT_L(n) asm volatile("s_waitcnt lgkmcnt(" #n ")" ::: "memory")
#define PG8_BAR __builtin_amdgcn_s_barrier()
#define PG8_SCHED __builtin_amdgcn_sched_barrier(0)
    Unit cur, nxt; int ui = 0;
    if (!S.next(0, cur)) return;
    if constexpr (Epi::PSTAGE) E.stage(cur, lds + LDS_PAR, tid);
    f32x4 acc[2][2][4][2];
#pragma unroll
    for (int a = 0; a < 2; ++a)
#pragma unroll
        for (int b = 0; b < 2; ++b)
#pragma unroll
            for (int m = 0; m < 4; ++m)
#pragma unroll
                for (int n = 0; n < 2; ++n) acc[a][b][m][n] = (f32x4){0.f, 0.f, 0.f, 0.f};
    bf16x8 At[4][2], B0[2][2], B1[2][2];
    const char* cA = cur.a; const char* cB = cur.b;
    if constexpr (SP2) {
        PG8_STAGE(PG8_SB(0, 0), cB, voffB); PG8_STAGE(PG8_SB(0, 1), cB + hB, voffB); PG8_STAGE(PG8_SA(0, 0), cA, voffA); PG8_STAGE(PG8_SA(0, 1), cA + hA, voffA);
        if (wr == 1) PG8_BAR;
        PG8_WAIT_V(2); PG8_BAR;
        PG8_STAGE(PG8_SB(1, 0), cB + kstep, voffB); PG8_STAGE(PG8_SA(1, 0), cA + kstepA, voffA); PG8_STAGE(PG8_SB(1, 1), cB + hB + kstep, voffB);
        PG8_WAIT_V(6); PG8_BAR;
    } else {
        PG8_STAGE(PG8_SB(0, 0), cB, voffB); PG8_STAGE(PG8_SA(0, 0), cA, voffA); PG8_STAGE(PG8_SB(0, 1), cB + hB, voffB); PG8_STAGE(PG8_SA(0, 1), cA + hA, voffA);
        if (wr == 1) PG8_BAR;
        PG8_WAIT_V(4); PG8_BAR;
        PG8_STAGE(PG8_SB(1, 0), cB + kstep, voffB); PG8_STAGE(PG8_SA(1, 0), cA + kstepA, voffA); PG8_STAGE(PG8_SB(1, 1), cB + hB + kstep, voffB);
        PG8_WAIT_V(6); PG8_BAR;
    }
    for (;;) {
        const bool has_next = S.next(ui + 1, nxt);
        const char* nA = has_next ? nxt.a : cA; const char* nB = has_next ? nxt.b : cB;
        for (int t = 0; t < nt; t += 2) {
            const bool last = (t == nt - 2);
            const char* a1 = cA + (size_t)(t + 1) * kstepA;
            const char* a2 = last ? nA : cA + (size_t)(t + 2) * kstepA; const char* b2 = last ? nB : cB + (size_t)(t + 2) * kstep;
            const char* a3 = a2 + kstepA; const char* b3 = b2 + kstep;
            if constexpr (SP2) {
            PG8_LDB(B0, 0, 0); PG8_LDB(B1, 0, 1); PG8_SCHED; PG8_LDA(At, 0, 0); PG8_STAGE(PG8_SA(1, 1), a1 + hA, voffA);
            PG8_WAIT_V(8); PG8_WAIT_L(0); PG8_BAR; PG8_MMA(0, 0, At, B0); PG8_MMA(0, 1, At, B1); PG8_BAR; PG8_SCHED;
            PG8_LDA(At, 0, 1); PG8_STAGE(PG8_SB(0, 0), b2, voffB); PG8_STAGE(PG8_SB(0, 1), b2 + hB, voffB); PG8_STAGE(PG8_SA(0, 0), a2, voffA);
            PG8_WAIT_V(8); PG8_WAIT_L(0); PG8_BAR; PG8_MMA(1, 0, At, B0); PG8_MMA(1, 1, At, B1); PG8_BAR; PG8_SCHED;
            PG8_LDB(B0, 1, 0); PG8_LDB(B1, 1, 1); PG8_SCHED; PG8_LDA(At, 1, 0); PG8_STAGE(PG8_SA(0, 1), a2 + hA, voffA);
            PG8_WAIT_V(8); PG8_WAIT_L(0); PG8_BAR; PG8_MMA(0, 0, At, B0); PG8_MMA(0, 1, At, B1); PG8_BAR; PG8_SCHED;
            PG8_LDA(At, 1, 1); PG8_STAGE(PG8_SB(1, 0), b3, voffB); PG8_STAGE(PG8_SB(1, 1), b3 + hB, voffB); PG8_STAGE(PG8_SA(1, 0), a3, voffA);
            PG8_WAIT_V(8); PG8_WAIT_L(0); PG8_BAR; PG8_MMA(1, 0, At, B0); PG8_MMA(1, 1, At, B1); PG8_BAR; PG8_SCHED;
            } else {
            PG8_LDB(B0, 0, 0); PG8_SCHED; PG8_LDA(At, 0, 0); PG8_STAGE(PG8_SA(1, 1), a1 + hA, voffA);
            PG8_WAIT_L(8); PG8_BAR; PG8_WAIT_L(0); PG8_MMA(0, 0, At, B0); PG8_BAR; PG8_SCHED;
            PG8_LDB(B1, 0, 1); PG8_STAGE(PG8_SB(0, 0), b2, voffB);
            PG8_BAR; PG8_WAIT_L(0); PG8_MMA(0, 1, At, B1); PG8_BAR;
            PG8_LDA(At, 0, 1); PG8_STAGE(PG8_SA(0, 0), a2, voffA);
            PG8_BAR; PG8_WAIT_L(0); PG8_MMA(1, 0, At, B0); PG8_BAR; PG8_SCHED;
            PG8_STAGE(PG8_SB(0, 1), b2 + hB, voffB);
            PG8_WAIT_V(6); PG8_BAR; PG8_MMA(1, 1, At, B1); PG8_BAR;
            PG8_LDB(B0, 1, 0); PG8_SCHED; PG8_LDA(At, 1, 0); PG8_STAGE(PG8_SA(0, 1), a2 + hA, voffA);
            PG8_WAIT_L(8); PG8_BAR; PG8_WAIT_L(0); PG8_MMA(0, 0, At, B0); PG8_BAR; PG8_SCHED;
            PG8_LDB(B1, 1, 1); PG8_STAGE(PG8_SB(1, 0), b3, voffB);
            PG8_BAR; PG8_WAIT_L(0); PG8_MMA(0, 1, At, B1); PG8_BAR;
            PG8_LDA(At, 1, 1); PG8_STAGE(PG8_SA(1, 0), a3, voffA);
            PG8_BAR; PG8_WAIT_L(0); PG8_MMA(1, 0, At, B0); PG8_BAR; PG8_SCHED;
            PG8_STAGE(PG8_SB(1, 1), b3 + hB, voffB);
            PG8_WAIT_V(6); PG8_BAR; PG8_MMA(1, 1, At, B1); PG8_BAR;
            }
        }
        if constexpr (ALIGN_EPI) { if (wr == 0) PG8_BAR; }
        E(acc, cur, wr, wc, fr, fq, (LAS const float*)(lds + LDS_PAR + (ui & 1) * 4096));
        if (!has_next) break;
#pragma unroll
        for (int a = 0; a < 2; ++a)
#pragma unroll
            for (int b = 0; b < 2; ++b)
#pragma unroll
                for (int m = 0; m < 4; ++m)
#pragma unroll
                    for (int n = 0; n < 2; ++n) acc[a][b][m][n] = (f32x4){0.f, 0.f, 0.f, 0.f};
        cur = nxt; cA = nA; cB = nB; ++ui;
        if constexpr (Epi::PSTAGE) E.stage(cur, lds + LDS_PAR + (ui & 1) * 4096, tid);
        if constexpr (ALIGN_EPI) { if (wr == 1) PG8_BAR; }
    }
    PG8_WAIT_V(0);
    if constexpr (!ALIGN_EPI) { if (wr == 0) PG8_BAR; }
    PG8_BAR;
#undef PG8_SA
#undef PG8_SB
#undef PG8_STAGE
#undef PG8_LDA
#undef PG8_LDB
#undef PG8_MMA
#undef PG8_WAIT_V
#undef PG8_WAIT_L
#undef PG8_BAR
#undef PG8_SCHED
}

struct EpiIn {
    static constexpr bool PERM = true, PSTAGE = true;
    __device__ __forceinline__ void stage(const Unit& u, LAS unsigned char* buf, int tid) const {
        const unsigned wv = (unsigned)__builtin_amdgcn_readfirstlane(tid >> 6);
        const float* g0 = (const float*)rs + (size_t)(u.pm * BM + (tid >> 1)) * rs_mul * 2 + (tid & 1);
        __builtin_amdgcn_global_load_lds((const unsigned*)g0, (LAS unsigned*)(buf + wv * 256u), 4, 0, 0);
        const float* g1 = (tid < 256 ? c1 : c2 - 256) + u.pn * BM + tid;
        __builtin_amdgcn_global_load_lds((const unsigned*)g1, (LAS unsigned*)(buf + 2048u + wv * 256u), 4, 0, 0);
    }
    bf16_t* out; int ldc; const f32x2* rs; int rs_mul; const float* c1; const float* c2; int act;
    __device__ __forceinline__ void operator()(f32x4 (&acc)[2][2][4][2], const Unit& u, int wr, int wc, int fr, int fq, LAS const float* pp) const {
        const int row0 = u.pm * BM + wr * 64 + fr, col0 = u.pn * BM + wc * 32 + 8 * fq;
        f32x4 c1v[2][2], c2v[2][2];
#pragma unroll
        for (int bj = 0; bj < 2; ++bj)
#pragma unroll
            for (int n = 0; n < 2; ++n) { c1v[bj][n] = *(const LAS f32x4*)(pp + 512 + wc * 32 + 8 * fq + bj * HALF + 4 * n); c2v[bj][n] = *(const LAS f32x4*)(pp + 768 + wc * 32 + 8 * fq + bj * HALF + 4 * n); }
        f32x2 stv[2][4];
#pragma unroll
        for (int ai = 0; ai < 2; ++ai)
#pragma unroll
            for (int m = 0; m < 4; ++m) stv[ai][m] = *(const LAS f32x2*)(pp + 2 * (wr * 64 + fr + ai * HALF + m * 16));
#pragma unroll
        for (int ai = 0; ai < 2; ++ai)
#pragma unroll
            for (int m = 0; m < 4; ++m) { const int r = row0 + ai * HALF + m * 16; const f32x2 st = stv[ai][m]; bf16_t* rowp = out + (size_t)r * ldc + col0;
#pragma unroll
                for (int bj = 0; bj < 2; ++bj) {
                    f32x4 v0 = (acc[ai][bj][m][0] - st.x * c1v[bj][0]) * st.y + c2v[bj][0], v1 = (acc[ai][bj][m][1] - st.x * c1v[bj][1]) * st.y + c2v[bj][1];
                    if (act == 1) {
#pragma unroll
                        for (int j = 0; j < 4; ++j) { const float a = fmaxf(v0[j], 0.f), b = fmaxf(v1[j], 0.f); v0[j] = a * a; v1[j] = b * b; } }
                    u32x4 w; w.x = cvt_pk_bf16(v0[0], v0[1]); w.y = cvt_pk_bf16(v0[2], v0[3]); w.z = cvt_pk_bf16(v1[0], v1[1]); w.w = cvt_pk_bf16(v1[2], v1[3]);
                    *(u32x4*)(rowp + bj * HALF) = w; } }
    }
};
struct EpiInT {
    static constexpr bool PERM = true, PSTAGE = true;
    __device__ __forceinline__ void stage(const Unit& u, LAS unsigned char* buf, int tid) const {
        const unsigned wv = (unsigned)__builtin_amdgcn_readfirstlane(tid >> 6);
        const float* g0 = (const float*)rs + (size_t)(u.pm * BM + (tid >> 1)) * rs_mul * 2 + (tid & 1);
        __builtin_amdgcn_global_load_lds((const unsigned*)g0, (LAS unsigned*)(buf + wv * 256u), 4, 0, 0);
        const float* g1 = (tid < 256 ? c1 : c2 - 256) + u.pn * BM + tid;
        __builtin_amdgcn_global_load_lds((const unsigned*)g1, (LAS unsigned*)(buf + 2048u + wv * 256u), 4, 0, 0);
    }
    bf16_t* out; int ldc; const f32x2* rs; int rs_mul; const float* c1; const float* c2; int act;
    __device__ __forceinline__ void operator()(f32x4 (&acc)[2][2][4][2], const Unit& u, int wr, int wc, int fr, int fq, LAS const float* pp) const {
        const int row0 = u.pm * BM + wr * 64 + fr, col0 = u.pn * BM + wc * 32 + 8 * fq;
        f32x4 c1v[2][2], c2v[2][2];
#pragma unroll
        for (int bj = 0; bj < 2; ++bj)
#pragma unroll
            for (int n = 0; n < 2; ++n) { c1v[bj][n] = *(const LAS f32x4*)(pp + 512 + wc * 32 + 8 * fq + bj * HALF + 4 * n); c2v[bj][n] = *(const LAS f32x4*)(pp + 768 + wc * 32 + 8 * fq + bj * HALF + 4 * n); }
        f32x2 stv[2][4];
#pragma unroll
        for (int ai = 0; ai < 2; ++ai)
#pragma unroll
            for (int m = 0; m < 4; ++m) stv[ai][m] = *(const LAS f32x2*)(pp + 2 * (wr * 64 + fr + ai * HALF + m * 16));
#pragma unroll
        for (int ai = 0; ai < 2; ++ai)
#pragma unroll
            for (int m = 0; m < 4; ++m) { const int r = row0 + ai * HALF + m * 16; const f32x2 st = stv[ai][m]; bf16_t* rowp = out + ((size_t)(r >> 4) * (ldc >> 5) + (col0 >> 5)) * 512 + (r & 15) * 32 + (col0 & 31);
#pragma unroll
                for (int bj = 0; bj < 2; ++bj) {
                    f32x4 v0 = (acc[ai][bj][m][0] - st.x * c1v[bj][0]) * st.y + c2v[bj][0], v1 = (acc[ai][bj][m][1] - st.x * c1v[bj][1]) * st.y + c2v[bj][1];
                    if (act == 1) {
#pragma unroll
                        for (int j = 0; j < 4; ++j) { const float a = fmaxf(v0[j], 0.f), b = fmaxf(v1[j], 0.f); v0[j] = a * a; v1[j] = b * b; } }
                    u32x4 w; w.x = cvt_pk_bf16(v0[0], v0[1]); w.y = cvt_pk_bf16(v0[2], v0[3]); w.z = cvt_pk_bf16(v1[0], v1[1]); w.w = cvt_pk_bf16(v1[2], v1[3]);
                    *(u32x4*)(rowp + bj * (HALF / 32) * 512) = w; } }
    }
};
struct EpiSoftmax {
    static constexpr bool PERM = true, PSTAGE = false;
    bf16_t* out; int ldc; float scale; LAS float* xl;
    const f32x2* rs; const float* c1; const float* c2;
    __device__ __forceinline__ void operator()(f32x4 (&acc)[2][2][4][2], const Unit& u, int wr, int wc, int fr, int fq, LAS const float* pp) const {
        const int col0 = u.pn * BM + wc * 32 + 8 * fq; const float sl2 = scale * 1.4426950408889634f;
        const int mb = u.pm < 64 ? (u.pm >> 3) : 8 + ((u.pm - 64) >> 4); const int cc = (mb * 4 + u.pn) * BM + wc * 32 + 8 * fq;
        f32x4 c1v[4], c2v[4];
#pragma unroll
        for (int q = 0; q < 4; ++q) { c1v[q] = *(const f32x4*)(c1 + cc + (q >> 1) * HALF + 4 * (q & 1)); c2v[q] = *(const f32x4*)(c2 + cc + (q >> 1) * HALF + 4 * (q & 1)); }
#pragma unroll
        for (int ai = 0; ai < 2; ++ai)
#pragma unroll
            for (int m = 0; m < 4; ++m) { const int rl = ai * HALF + wr * 64 + m * 16 + fr; const f32x2 st = rs[u.pm * BM + rl];
                f32x4 a0 = ((acc[ai][0][m][0] - st.x * c1v[0]) * st.y + c2v[0]) * sl2, a1 = ((acc[ai][0][m][1] - st.x * c1v[1]) * st.y + c2v[1]) * sl2;
                f32x4 a2 = ((acc[ai][1][m][0] - st.x * c1v[2]) * st.y + c2v[2]) * sl2, a3 = ((acc[ai][1][m][1] - st.x * c1v[3]) * st.y + c2v[3]) * sl2;
                float mx = fmaxf(fmaxf(fmaxf(a0[0], a0[1]), fmaxf(a0[2], a0[3])), fmaxf(fmaxf(a1[0], a1[1]), fmaxf(a1[2], a1[3])));
                mx = fmaxf(mx, fmaxf(fmaxf(fmaxf(a2[0], a2[1]), fmaxf(a2[2], a2[3])), fmaxf(fmaxf(a3[0], a3[1]), fmaxf(a3[2], a3[3]))));
                mx = max_x32(max_x16(mx));
                float sm = 0.f;
#pragma unroll
                for (int j = 0; j < 4; ++j) { a0[j] = __builtin_amdgcn_exp2f(a0[j] - mx); a1[j] = __builtin_amdgcn_exp2f(a1[j] - mx); a2[j] = __builtin_amdgcn_exp2f(a2[j] - mx); a3[j] = __builtin_amdgcn_exp2f(a3[j] - mx);
                    sm += (a0[j] + a1[j]) + (a2[j] + a3[j]); }
                sm = sum_x32(sum_x16(sm));
                acc[ai][0][m][0] = a0; acc[ai][0][m][1] = a1; acc[ai][1][m][0] = a2; acc[ai][1][m][1] = a3;
                if (fq == 0) *(LAS f32x2*)(xl + (rl * 4 + wc) * 2) = (f32x2){mx, sm}; }
        asm volatile("s_waitcnt lgkmcnt(0)" ::: "memory"); __builtin_amdgcn_s_barrier(); asm volatile("" ::: "memory");
#pragma unroll
        for (int ai = 0; ai < 2; ++ai)
#pragma unroll
            for (int m = 0; m < 4; ++m) { int rl = ai * HALF + wr * 64 + m * 16 + fr; asm volatile("" : "+v"(rl));
                const f32x4 t0 = *(const LAS f32x4*)(xl + rl * 8), t1 = *(const LAS f32x4*)(xl + rl * 8 + 4);
                const float M = fmaxf(fmaxf(t0[0], t0[2]), fmaxf(t1[0], t1[2]));
                const float Lsum = (t0[1] * __builtin_amdgcn_exp2f(t0[0] - M) + t0[3] * __builtin_amdgcn_exp2f(t0[2] - M)) + (t1[1] * __builtin_amdgcn_exp2f(t1[0] - M) + t1[3] * __builtin_amdgcn_exp2f(t1[2] - M));
                const float mine = (wc == 0) ? t0[0] : (wc == 1) ? t0[2] : (wc == 2) ? t1[0] : t1[2];
                const float f = __builtin_amdgcn_exp2f(mine - M) * __builtin_amdgcn_rcpf(Lsum);
                bf16_t* rowp = out + tile_off(u.pm * BM + rl, col0, ldc);
#pragma unroll
                for (int bj = 0; bj < 2; ++bj) { const f32x4 v0 = acc[ai][bj][m][0] * f, v1 = acc[ai][bj][m][1] * f;
                    u32x4 w; w.x = cvt_pk_bf16(v0[0], v0[1]); w.y = cvt_pk_bf16(v0[2], v0[3]); w.z = cvt_pk_bf16(v1[0], v1[1]); w.w = cvt_pk_bf16(v1[2], v1[3]);
                    *(u32x4*)(rowp + bj * (HALF / 32) * 512) = w; } }
    }
};
struct EpiRes {
    static constexpr bool PERM = true, PSTAGE = false;
    bf16_t* zb; const f32x2* rs; int rs_mul; const float* g; const float* b; f32x2* P;
    __device__ __forceinline__ void operator()(f32x4 (&acc)[2][2][4][2], const Unit& u, int wr, int wc, int fr, int fq, LAS const float* pp) const {
        const int row0 = u.pm * BM + wr * 64 + fr, col0 = u.pn * BM + wc * 32 + 8 * fq;
        f32x4 gv[2][2], bv[2][2];
#pragma unroll
        for (int bj = 0; bj < 2; ++bj)
#pragma unroll
            for (int n = 0; n < 2; ++n) { gv[bj][n] = *(const f32x4*)(g + col0 + bj * HALF + 4 * n); bv[bj][n] = *(const f32x4*)(b + col0 + bj * HALF + 4 * n); }
        u32x4 zw[4][2]; f32x2 stv[4];
#pragma unroll
        for (int m = 0; m < 4; ++m) { const int r = row0 + m * 16; stv[m] = rs[(size_t)r * rs_mul];
#pragma unroll
            for (int bj = 0; bj < 2; ++bj) zw[m][bj] = *(const u32x4*)(zb + tile_off(r, col0, DM) + bj * (HALF / 32) * 512); }
#pragma unroll
        for (int ai = 0; ai < 2; ++ai)
#pragma unroll
            for (int m = 0; m < 4; ++m) { const int r = row0 + ai * HALF + m * 16; const f32x2 st = stv[m]; bf16_t* zp = zb + tile_off(r, col0, DM);
                const float nm = -st.x * st.y;
                f32x4 sv = {0.f, 0.f, 0.f, 0.f}, qv = {0.f, 0.f, 0.f, 0.f};
#pragma unroll
                for (int bj = 0; bj < 2; ++bj) {
                    const u32x4 zq = zw[m][bj];
                    const f32x4 zo0 = {bf2f(zq.x & 0xffffu), bf2f(zq.x >> 16), bf2f(zq.y & 0xffffu), bf2f(zq.y >> 16)}, zo1 = {bf2f(zq.z & 0xffffu), bf2f(zq.z >> 16), bf2f(zq.w & 0xffffu), bf2f(zq.w >> 16)};
                    const f32x4 x0 = (zo0 * st.y + nm) * gv[bj][0] + bv[bj][0], x1 = (zo1 * st.y + nm) * gv[bj][1] + bv[bj][1];
                    const f32x4 n0 = x0 * DN_ALPHA + acc[ai][bj][m][0], n1 = x1 * DN_ALPHA + acc[ai][bj][m][1];
                    u32x4 w; w.x = cvt_pk_bf16(n0[0], n0[1]); w.y = cvt_pk_bf16(n0[2], n0[3]); w.z = cvt_pk_bf16(n1[0], n1[1]); w.w = cvt_pk_bf16(n1[2], n1[3]);
                    *(u32x4*)(zp + bj * (HALF / 32) * 512) = w;
                    sv += n0; sv += n1; qv = n0 * n0 + qv; qv = n1 * n1 + qv; }
                if (ai == 0) { const int r2 = r + HALF; stv[m] = rs[(size_t)r2 * rs_mul];
#pragma unroll
                    for (int bj = 0; bj < 2; ++bj) zw[m][bj] = *(const u32x4*)(zb + tile_off(r2, col0, DM) + bj * (HALF / 32) * 512); }
                float s = (sv[0] + sv[1]) + (sv[2] + sv[3]), ss = (qv[0] + qv[1]) + (qv[2] + qv[3]);
                s = sum_x32(sum_x16(s)); ss = sum_x32(sum_x16(ss));
                if (fq == 0) P[(size_t)(u.pn * 4 + wc) * NTOK + r] = (f32x2){s, ss}; }
    }
};
struct EpiQKV {
    static constexpr bool PERM = true, PSTAGE = false;
    bf16_t* out; const f32x2* rs; int rs_mul; const float* c1; const float* c2; const float* qg; const float* kg; const f32x2* tab; LAS float* xl;
    __device__ __forceinline__ void operator()(f32x4 (&acc)[2][2][4][2], const Unit& u, int wr, int wc, int fr, int fq, LAS const float* pp) const {
        const int row0 = u.pm * BM + wr * 64 + fr, col0 = u.pn * BM + wc * 32 + 8 * fq;
        const bool isv = u.pn >= 10;
        f32x4 c1q[2][2], c2q[2][2]; f32x2 stq[2][4];
#pragma unroll
        for (int bj = 0; bj < 2; ++bj) { c1q[bj][0] = *(const f32x4*)(c1 + col0 + bj * HALF); c1q[bj][1] = *(const f32x4*)(c1 + col0 + bj * HALF + 4); c2q[bj][0] = *(const f32x4*)(c2 + col0 + bj * HALF); c2q[bj][1] = *(const f32x4*)(c2 + col0 + bj * HALF + 4); }
#pragma unroll
        for (int ai = 0; ai < 2; ++ai)
#pragma unroll
            for (int m = 0; m < 4; ++m) stq[ai][m] = rs[(size_t)(u.pm * BM + ai * HALF + wr * 64 + m * 16 + fr) * rs_mul];
#pragma unroll
        for (int bj = 0; bj < 2; ++bj) {
            const f32x4 c10 = c1q[bj][0], c11 = c1q[bj][1], c20 = c2q[bj][0], c21 = c2q[bj][1];
#pragma unroll
            for (int ai = 0; ai < 2; ++ai)
#pragma unroll
                for (int m = 0; m < 4; ++m) { int rl = ai * HALF + wr * 64 + m * 16 + fr; asm volatile("" : "+v"(rl)); const f32x2 st = stq[ai][m];
                    const f32x4 v0 = (acc[ai][bj][m][0] - st.x * c10) * st.y + c20, v1 = (acc[ai][bj][m][1] - st.x * c11) * st.y + c21;
                    acc[ai][bj][m][0] = v0; acc[ai][bj][m][1] = v1;
                    if (!isv) { float ss = (v0[0] * v0[0] + v0[1] * v0[1]) + (v0[2] * v0[2] + v0[3] * v0[3]) + (v1[0] * v1[0] + v1[1] * v1[1]) + (v1[2] * v1[2] + v1[3] * v1[3]);
                        ss = sum_x32(sum_x16(ss));
                        if (fq == 0) xl[(rl * 2 + bj) * 4 + wc] = ss; } }
            asm volatile("" ::: "memory"); }
        if (isv) {
#pragma unroll
            for (int ai = 0; ai < 2; ++ai)
#pragma unroll
                for (int m = 0; m < 4; ++m) { int rr = row0 + ai * HALF + m * 16; asm volatile("" : "+v"(rr)); bf16_t* rowp = out + (size_t)rr * ATT_IN + col0;
#pragma unroll
                    for (int bj = 0; bj < 2; ++bj) { const f32x4 v0 = acc[ai][bj][m][0], v1 = acc[ai][bj][m][1];
                        u32x4 w; w.x = cvt_pk_bf16(v0[0], v0[1]); w.y = cvt_pk_bf16(v0[2], v0[3]); w.z = cvt_pk_bf16(v1[0], v1[1]); w.w = cvt_pk_bf16(v1[2], v1[3]);
                        *(u32x4*)(rowp + bj * HALF) = w; } }
        }
        asm volatile("s_waitcnt lgkmcnt(0)" ::: "memory"); __builtin_amdgcn_s_barrier(); asm volatile("" ::: "memory");
        if (!isv) {
            const int sec = wc >> 1, xi = (wc & 1) * 16 + fq * 4, e1 = sec * 64 + xi;
            const float* gn = (u.pn < 8) ? qg : kg;
            const f32x4 g1 = *(const f32x4*)(gn + e1), g2 = *(const f32x4*)(gn + e1 + 32);
            auto cs_row = [&](int q_) -> const f32x2* { int rl_ = (q_ >> 2) * HALF + wr * 64 + (q_ & 3) * 16 + fr; const int r_ = u.pm * BM + rl_;
                const int pos_ = r_ < NPR ? (r_ & 2047) : (r_ & 4095); const int pid_ = sec == 0 ? (pos_ >> 6) : (pos_ & 63); return tab + pid_ * 32 + xi; };
            f32x4 csn01 = *(const f32x4*)cs_row(0), csn23 = *(const f32x4*)(cs_row(0) + 2);
#pragma unroll
            for (int ai = 0; ai < 2; ++ai)
#pragma unroll
                for (int m = 0; m < 4; ++m) { int rl = ai * HALF + wr * 64 + m * 16 + fr; asm volatile("" : "+v"(rl));
                    const int r = u.pm * BM + rl;
                    const f32x4 cs01 = csn01, cs23 = csn23;
                    if (ai * 4 + m < 7) { const f32x2* nx_ = cs_row(ai * 4 + m + 1); csn01 = *(const f32x4*)nx_; csn23 = *(const f32x4*)(nx_ + 2); }
                    const f32x4 cv = {cs01[0], cs01[2], cs23[0], cs23[2]}, sv = {cs01[1], cs01[3], cs23[1], cs23[3]};
#pragma unroll
                    for (int bj = 0; bj < 2; ++bj) {
                        const f32x4 t = *(const LAS f32x4*)(xl + (rl * 2 + bj) * 4);
                        const float rn = 1.0f / sqrtf(((t[0] + t[1]) + (t[2] + t[3])) * (1.f / 128.f) + RMS_EPS);
                        const f32x4 x1 = acc[ai][bj][m][0] * rn * g1, x2 = acc[ai][bj][m][1] * rn * g2;
                        const f32x4 o1 = x1 * cv - x2 * sv, o2 = x1 * sv + x2 * cv;
                        bf16_t* hp = out + (size_t)r * ATT_IN + col0 + bj * HALF;
                        u32x4 w; w.x = cvt_pk_bf16(o1[0], o1[1]); w.y = cvt_pk_bf16(o1[2], o1[3]); w.z = cvt_pk_bf16(o2[0], o2[1]); w.w = cvt_pk_bf16(o2[2], o2[3]);
                        *(u32x4*)hp = w; }
                    asm volatile("" ::: "memory"); }
        }
    }
};
}

namespace att {
constexpr int D = 128, NW = 8, QBLK = 32, KVBLK = 64;
constexpr float SCALE = 0.088388347648318440f, THR = 8.f;
constexpr int LDQ = ATT_IN, LDK = ATT_IN, LDO = DM;
constexpr size_t SHM_V = KVBLK * D * 2, SHM_K = KVBLK * D * 2, SHM_ATTN = 2 * SHM_V + 2 * SHM_K + NW * 64 * 4;
#define KSWZ(row, colB) ((row) * 256 + ((colB) ^ (((row) & 7) << 4)))
#define SBAR() __builtin_amdgcn_sched_barrier(0)
__device__ __forceinline__ int crow(int r, int hi) { return (r & 3) + 8 * (r >> 2) + 4 * hi; }
__device__ __forceinline__ void partialSM(f32x16& p0, f32x16& p1, float& m_reg, float& mn, float& alpha) {
  constexpr float C = SCALE * 1.4426950408889634f;
  float pmax = p0[0]; for (int r = 1; r < 16; ++r) pmax = fmaxf(pmax, p0[r]); for (int r = 0; r < 16; ++r) pmax = fmaxf(pmax, p1[r]);
  { auto rr = __builtin_amdgcn_permlane32_swap(__float_as_uint(pmax), __float_as_uint(pmax), false, false);
    pmax = fmaxf(__uint_as_float(rr[0]), __uint_as_float(rr[1])); }
  if (__builtin_expect(__all(pmax - m_reg <= THR / SCALE), 1)) { mn = m_reg; alpha = 1.f; }
  else { mn = fmaxf(m_reg, pmax); alpha = __builtin_amdgcn_exp2f((m_reg - mn) * C); m_reg = mn; }
  float mnC = -mn * C;
  for (int r = 0; r < 16; ++r) p0[r] = fmaf(p0[r], C, mnC); for (int r = 0; r < 16; ++r) p1[r] = fmaf(p1[r], C, mnC);
  for (int r = 0; r < 16; ++r) p0[r] = __builtin_amdgcn_exp2f(p0[r]);
}
__device__ __forceinline__ void finishSM(f32x16& p0, f32x16& p1, float alpha, float& l_reg, bf16x8& pa0, bf16x8& pa1, bf16x8& pa2, bf16x8& pa3) {
  for (int r = 0; r < 16; ++r) p1[r] = __builtin_amdgcn_exp2f(p1[r]);
  float ps = 0; for (int r = 0; r < 16; ++r) ps += p0[r]; for (int r = 0; r < 16; ++r) ps += p1[r];
  { auto rr = __builtin_amdgcn_permlane32_swap(__float_as_uint(ps), __float_as_uint(ps), false, false);
    ps = __uint_as_float(rr[0]) + __uint_as_float(rr[1]); }
  l_reg = l_reg * alpha + ps;
#define PK4(P, BASE, OUT) do { unsigned a0 = cvt_pk_bf16(P[BASE + 0], P[BASE + 1]), a1 = cvt_pk_bf16(P[BASE + 2], P[BASE + 3]);   \
    unsigned b0 = cvt_pk_bf16(P[BASE + 4], P[BASE + 5]), b1 = cvt_pk_bf16(P[BASE + 6], P[BASE + 7]);                              \
    auto r0 = __builtin_amdgcn_permlane32_swap(a0, b0, false, false); auto r1 = __builtin_amdgcn_permlane32_swap(a1, b1, false, false); \
    u32x4 w = {r0[0], r1[0], r0[1], r1[1]}; OUT = *reinterpret_cast<bf16x8*>(&w); } while (0)
  PK4(p0, 0, pa0); PK4(p0, 8, pa1); PK4(p1, 0, pa2); PK4(p1, 8, pa3);
#undef PK4
}
__device__ __forceinline__ void qkt(f32x16& p0, f32x16& p1, const bf16_t* Ks, const bf16x8* qr, int r32, int hi) {
  p0 = f32x16{}; p1 = f32x16{};
  for (int d0 = 0; d0 < 8; ++d0) { int cb = (d0 * 16 + hi * 8) * 2;
    bf16x8 b0 = *reinterpret_cast<const bf16x8*>((const char*)Ks + KSWZ(r32, cb));
    bf16x8 b1 = *reinterpret_cast<const bf16x8*>((const char*)Ks + KSWZ(32 + r32, cb));
    p0 = __builtin_amdgcn_mfma_f32_32x32x16_bf16(b0, qr[d0], p0, 0, 0, 0);
    p1 = __builtin_amdgcn_mfma_f32_32x32x16_bf16(b1, qr[d0], p1, 0, 0, 0); }
}
__device__ __forceinline__ int v_st(int k, int c) { const int kk = (k & ~0xC) | ((k & 4) << 1) | ((k & 8) >> 1); return ((kk >> 3) * 4 + (c >> 5)) * 512 + ((kk & 7) * 32 + (c & 31)) * 2; }
__device__ __forceinline__ int v_rd_base(int lane) { return ((lane & 3) << 3) | (((lane >> 2) & 3) << 6) | (((lane >> 4) & 1) << 5) | (((lane >> 5) & 1) << 8); }
constexpr int v_rd_off(int d0, int ks, int half) { return d0 * 512 + ks * 4096 + half * 2048; }
template <int OFF> __device__ __forceinline__ s16x4 tr_read(int vb) {
  s16x4 r; asm volatile("ds_read_b64_tr_b16 %0, %1 offset:%2" : "=&v"(r) : "v"(vb), "i"(OFF) : "memory"); return r;
}
template <int D0> __device__ __forceinline__ void pv_one(f32x16& od, int vb, bf16x8 pa0, bf16x8 pa1, bf16x8 pa2, bf16x8 pa3) {
  const s16x4 l0 = tr_read<v_rd_off(D0, 0, 0)>(vb), h0 = tr_read<v_rd_off(D0, 0, 1)>(vb), l1 = tr_read<v_rd_off(D0, 1, 0)>(vb), h1 = tr_read<v_rd_off(D0, 1, 1)>(vb);
  const s16x4 l2 = tr_read<v_rd_off(D0, 2, 0)>(vb), h2 = tr_read<v_rd_off(D0, 2, 1)>(vb), l3 = tr_read<v_rd_off(D0, 3, 0)>(vb), h3 = tr_read<v_rd_off(D0, 3, 1)>(vb);
  asm volatile("s_waitcnt lgkmcnt(0)" ::: "memory"); SBAR();
#define PK(L, H) (bf16x8){L[0], L[1], L[2], L[3], H[0], H[1], H[2], H[3]}
  od = __builtin_amdgcn_mfma_f32_32x32x16_bf16(pa0, PK(l0, h0), od, 0, 0, 0);
  od = __builtin_amdgcn_mfma_f32_32x32x16_bf16(pa1, PK(l1, h1), od, 0, 0, 0);
  od = __builtin_amdgcn_mfma_f32_32x32x16_bf16(pa2, PK(l2, h2), od, 0, 0, 0);
  od = __builtin_amdgcn_mfma_f32_32x32x16_bf16(pa3, PK(l3, h3), od, 0, 0, 0);
#undef PK
}
__device__ __forceinline__ void pv_d0(f32x16* o, int vb, bf16x8 pa0, bf16x8 pa1, bf16x8 pa2, bf16x8 pa3) {
  pv_one<0>(o[0], vb, pa0, pa1, pa2, pa3); pv_one<1>(o[1], vb, pa0, pa1, pa2, pa3); pv_one<2>(o[2], vb, pa0, pa1, pa2, pa3); pv_one<3>(o[3], vb, pa0, pa1, pa2, pa3);
}
__device__ __forceinline__ void attn_dense_body(const bf16_t* __restrict__ Qb, const bf16_t* __restrict__ Kh, const bf16_t* __restrict__ Vh, bf16_t* __restrict__ Ob, int orow0, int ocol0, int seq, char* lds) {
  const int tid = opaque_tid(), wid = tid >> 6, lane = tid & 63, r32 = lane & 31, hi = lane >> 5;
  bf16_t* V_lds = (bf16_t*)lds; bf16_t* K_lds = (bf16_t*)(lds + 2 * SHM_V);
  float* ws = (float*)(lds + 2 * SHM_V + 2 * SHM_K) + wid * 64; float* li_l = ws; float* al_l = ws + 32;
  float m_reg = -1e30f, l_reg = 0; f32x16 o[4] = {}; bf16x8 qr[8];
  const bf16_t* Qw = Qb + (long)(wid * QBLK + r32) * LDQ + hi * 8;
#pragma unroll
  for (int d0 = 0; d0 < 8; ++d0) qr[d0] = *reinterpret_cast<const bf16x8*>(Qw + d0 * 16);
  const int sr = tid >> 4, sc = (tid & 15) * 8, vst0 = v_st(sr, sc), vst1 = v_st(32 + sr, sc);
  const int vb0 = (int)(uintptr_t)V_lds + v_rd_base(lane);
  struct { bf16x8 vs0, vs1, ks0, ks1; } sr_[2];
#define SLOAD(i, k0) do { sr_[i].vs0 = *reinterpret_cast<const bf16x8*>(&Vh[(long)((k0) + sr) * LDK + sc]); sr_[i].vs1 = *reinterpret_cast<const bf16x8*>(&Vh[(long)((k0) + 32 + sr) * LDK + sc]); \
    sr_[i].ks0 = *reinterpret_cast<const bf16x8*>(&Kh[(long)((k0) + sr) * LDK + sc]); sr_[i].ks1 = *reinterpret_cast<const bf16x8*>(&Kh[(long)((k0) + 32 + sr) * LDK + sc]); } while (0)
#define SWRITE(b, i) do { *(bf16x8*)((char*)V_lds + (b) * SHM_V + vst0) = sr_[i].vs0;          \
    *(bf16x8*)((char*)V_lds + (b) * SHM_V + vst1) = sr_[i].vs1; int kc = sc * 2;               \
    *(bf16x8*)((char*)K_lds + (b) * SHM_K + KSWZ(sr, kc)) = sr_[i].ks0;                       \
    *(bf16x8*)((char*)K_lds + (b) * SHM_K + KSWZ(32 + sr, kc)) = sr_[i].ks1; } while (0)
#define SWAIT() asm volatile("s_waitcnt vmcnt(4)" ::: "memory")
#define RESC(a) do { if (__any((a) < 1.f)) { if (hi == 0) al_l[r32] = (a); asm volatile("s_waitcnt lgkmcnt(0)" ::: "memory"); \
    for (int d = 0; d < 4; ++d) for (int r = 0; r < 16; ++r) o[d][r] *= al_l[crow(r, hi)]; } } while (0)
  f32x16 pA0, pA1, pB0, pB1; float mnA, mnB, alA, alB; bf16x8 pa0, pa1, pa2, pa3; const int NT = seq / KVBLK;
  constexpr int SE = 0, SO = 1;
  SLOAD(SE, 0); SLOAD(SO, KVBLK); asm volatile("s_waitcnt vmcnt(4)" ::: "memory"); SWRITE(0, SE); __syncthreads();
  if (2 < NT) SLOAD(SE, 2 * KVBLK);
  qkt(pA0, pA1, K_lds, qr, r32, hi); partialSM(pA0, pA1, m_reg, mnA, alA);
  SWAIT(); SWRITE(1, SO); __syncthreads();
  for (int j = 1; j + 1 < NT; j += 2) {
    SBAR(); qkt(pB0, pB1, (bf16_t*)((char*)K_lds + SHM_K), qr, r32, hi);
    finishSM(pA0, pA1, alA, l_reg, pa0, pa1, pa2, pa3); SBAR();
    SLOAD(SO, (j + 2) * KVBLK); SBAR();
    pv_d0(o, vb0, pa0, pa1, pa2, pa3); partialSM(pB0, pB1, m_reg, mnB, alB);
    __syncthreads(); SWAIT(); SWRITE(0, SE);
    RESC(alB); __syncthreads();
    SBAR(); qkt(pA0, pA1, K_lds, qr, r32, hi);
    finishSM(pB0, pB1, alB, l_reg, pa0, pa1, pa2, pa3); SBAR();
    if (j + 3 < NT) SLOAD(SE, (j + 3) * KVBLK); SBAR();
    pv_d0(o, vb0 + (int)SHM_V, pa0, pa1, pa2, pa3); partialSM(pA0, pA1, m_reg, mnA, alA);
    __syncthreads(); SWAIT(); SWRITE(1, SO);
    RESC(alA); __syncthreads();
  }
  SBAR(); qkt(pB0, pB1, (bf16_t*)((char*)K_lds + SHM_K), qr, r32, hi);
  finishSM(pA0, pA1, alA, l_reg, pa0, pa1, pa2, pa3); SBAR();
  pv_d0(o, vb0, pa0, pa1, pa2, pa3); partialSM(pB0, pB1, m_reg, mnB, alB);
  __syncthreads(); RESC(alB);
  finishSM(pB0, pB1, alB, l_reg, pa0, pa1, pa2, pa3); SBAR();
  pv_d0(o, vb0 + (int)SHM_V, pa0, pa1, pa2, pa3);
  if (hi == 0) li_l[r32] = l_reg; asm volatile("s_waitcnt lgkmcnt(0)" ::: "memory");
  float rli[16];
#pragma unroll
  for (int r = 0; r < 16; ++r) rli[r] = __builtin_amdgcn_rcpf(li_l[crow(r, hi)]);
  { const bool odd = (lane & 1) != 0; const int c2 = r32 & ~1;
    bf16_t* Ow = Ob + tile_off(orow0 + wid * QBLK + 4 * hi + (odd ? 1 : 0), ocol0 + c2, LDO);
#pragma unroll
    for (int p = 0; p < 8; ++p) { const int ra = 2 * p, rb = 2 * p + 1;
      const int rowoff = ((ra & 3) + 8 * (ra >> 2));
      const size_t eoff = (size_t)(rowoff >> 4) * (LDO >> 5) * 512 + (size_t)(rowoff & 15) * 32;
#pragma unroll
      for (int d0 = 0; d0 < 4; ++d0) { const float a = o[d0][ra] * rli[ra], b = o[d0][rb] * rli[rb];
        const float snd = odd ? a : b; const float rcv = __int_as_float(__builtin_amdgcn_mov_dpp(__float_as_int(snd), 0xB1, 0xf, 0xf, true));
        const unsigned w = odd ? cvt_pk_bf16(rcv, b) : cvt_pk_bf16(a, rcv);
        *(unsigned*)(Ow + eoff + d0 * 512) = w; } } }
  __syncthreads();
#undef SLOAD
#undef SWRITE
#undef SWAIT
#undef RESC
}
}

#define XB_TMO      128
#define XB_XCNT(j)  (256  + 64 * (j))
#define XB_XSUB(j)  (1280 + 64 * (j))
#define XB_XGEN(j)  (2304 + 64 * (j))
#define XB_TOP      3328
#define XB_TOPGEN   3392
#define XCD_BAR_WORDS 3456
#define XB_SPIN_CAP (1u << 18)
__device__ __forceinline__ unsigned xb_ld(unsigned* p)              { return __hip_atomic_load(p, __ATOMIC_RELAXED, __HIP_MEMORY_SCOPE_AGENT); }
__device__ __forceinline__ unsigned xb_add(unsigned* p, unsigned v) { return __hip_atomic_fetch_add(p, v, __ATOMIC_RELAXED, __HIP_MEMORY_SCOPE_AGENT); }
__device__ __forceinline__ unsigned xb_xcc_id() { return (unsigned)__builtin_amdgcn_s_getreg((3 << 11) | 20) & 0xFu; }
#define XB_SPIN(cond, bar) do { unsigned _sp = 0; while (cond) { __builtin_amdgcn_s_sleep(1); \
    if ((++_sp & 255u) == 0u) { if (xb_ld(&(bar)[XB_TMO])) break; if (_sp > XB_SPIN_CAP) { atomicAdd(&(bar)[XB_TMO], 1u); break; } } } } while (0)
struct XcdBarrier { unsigned* bar; unsigned x; volatile LAS unsigned* st; };
__device__ __forceinline__ XcdBarrier xcd_barrier_post(unsigned* bar, volatile LAS unsigned* st) {
    XcdBarrier b; b.bar = bar; b.x = xb_xcc_id(); b.st = st;
    if (threadIdx.x == 0) (void)xb_add(&bar[XB_XCNT(b.x)], 1u);
    return b;
}
__device__ __forceinline__ void xcd_barrier_complete(unsigned* bar, unsigned x, unsigned& nloc, unsigned& nx) {
    const unsigned G = gridDim.x * gridDim.y * gridDim.z;
    unsigned sum, cnt, mine, sp = 0u;
    for (;;) {
        sum = 0u; cnt = 0u; mine = 0u;
#pragma unroll
        for (unsigned j = 0; j < 16; ++j) { const unsigned c = xb_ld(&bar[XB_XCNT(j)]); sum += c; cnt += (c > 0u) ? 1u : 0u; mine = (j == x) ? c : mine; }
        if (sum == G) break;
        __builtin_amdgcn_s_sleep(1);
        if ((++sp & 255u) == 0u) { if (xb_ld(&bar[XB_TMO])) break; if (sp > XB_SPIN_CAP) { atomicAdd(&bar[XB_TMO], 1u); break; } }
    }
    nloc = mine > 0u ? mine : 1u; nx = cnt > 0u ? cnt : 1u;
}
__device__ __forceinline__ void xcd_barrier(const XcdBarrier& b) {
    asm volatile("s_waitcnt vmcnt(0)" ::: "memory");
    __syncthreads();
    if (threadIdx.x == 0) {
        unsigned* bar = b.bar;
        __builtin_amdgcn_s_waitcnt(0);
        unsigned nloc = b.st[0], nx = b.st[1];
        if (nloc == 0u) { xcd_barrier_complete(bar, b.x, nloc, nx); b.st[0] = nloc; b.st[1] = nx; }
        const unsigned old = xb_add(&bar[XB_XSUB(b.x)], 1u);
        const unsigned gen = old / nloc;
        if (old + 1u == (gen + 1u) * nloc) {
            __builtin_amdgcn_fence(__ATOMIC_RELEASE, "agent");
            asm volatile("s_waitcnt vmcnt(0)" ::: "memory");
            const unsigned og = xb_add(&bar[XB_TOP], 1u);
            const unsigned tg = og / nx;
            if (og + 1u == (tg + 1u) * nx) xb_add(&bar[XB_TOPGEN], 1u);
            else XB_SPIN(xb_ld(&bar[XB_TOPGEN]) == tg, bar);
            __builtin_amdgcn_fence(__ATOMIC_ACQUIRE, "agent");
            xb_add(&bar[XB_XGEN(b.x)], 1u);
            asm volatile("s_waitcnt vmcnt(0)" ::: "memory");
        } else {
            XB_SPIN(xb_ld(&bar[XB_XGEN(b.x)]) == gen, bar);
            __builtin_amdgcn_fence(__ATOMIC_ACQUIRE, "agent");
            asm volatile("s_waitcnt vmcnt(0)" ::: "memory");
        }
    }
    __syncthreads();
}

struct Args { const float* in[19]; float* out; unsigned char* ws; int ph_lo, ph_hi; };
enum { IN_XP = 0, IN_XS, IN_MEMP, IN_MEMS, IN_ATT_WIN, IN_QGAIN, IN_KGAIN, IN_ATT_WOUT, IN_ML_WIN, IN_ML_BGATE, IN_ML_HGAIN, IN_ML_WOUT, IN_XA_WQ, IN_XA_WKV, IN_XA_WOUT, IN_W1, IN_W2, IN_LNG, IN_LNB };
constexpr int MLP_NB = 1, PH_LAYER0 = 2, SLOTS = 14 + 2 * MLP_NB + 1, PH_FINAL = PH_LAYER0 + 4 * SLOTS, PH_END = PH_FINAL + 1;

struct TJob { const float* W; int K, N, ldw; bf16_t* dst; const float* g; const float* b; f32x2* cpart; int qkperm; int nat; };
typedef const __attribute__((address_space(4))) Args* KArgsT;
__device__ __forceinline__ void make_tjob(int j, KArgsT ap, TJob& J) {
    unsigned char* ws = ap->ws; const float* lng = ap->in[IN_LNG]; const float* lnb = ap->in[IN_LNB];
    f32x2* cp = (f32x2*)(ws + S_CPART); J.g = nullptr; J.b = nullptr; J.cpart = nullptr; J.qkperm = (j < 2) ? 1 : 0; J.nat = (j >= 8 && j < 12) ? 1 : 0;
    int lnidx = -1, cv = 0;
    if (j < 2)       { const int q = j;      J.W = ap->in[IN_ATT_WIN] + (size_t)q * DM * ATT_IN; J.K = DM; J.N = ATT_IN; J.ldw = ATT_IN; J.dst = (bf16_t*)(ws + W_ATT_IN) + (size_t)q * ATT_IN * DM; if (q == 1) { lnidx = 1 * 3 + 2; cv = CV_ATT_IN; } }
    else if (j < 4)  { const int q = j - 2;  J.W = ap->in[IN_ATT_WOUT] + (size_t)q * DM * DM; J.K = DM; J.N = DM; J.ldw = DM; J.dst = (bf16_t*)(ws + W_ATT_OUT) + (size_t)q * DM * DM; }
    else if (j < 6)  { const int q = j - 4;  J.W = ap->in[IN_ML_WIN] + (size_t)q * DM * ML_IN; J.K = DM; J.N = ML_IN; J.ldw = ML_IN; J.dst = (bf16_t*)(ws + W_ML_IN + (size_t)q * 25 * MiB); lnidx = (2 * q) * 3 + 2; cv = CV_ML_IN + q * ML_IN; }
    else if (j < 8)  { const int q = j - 6;  J.W = ap->in[IN_ML_WOUT] + (size_t)q * DM * DM; J.K = DM; J.N = DM; J.ldw = DM; J.dst = (bf16_t*)(ws + W_ML_OUT) + (size_t)q * DM * DM; }
    else if (j < 12) { const int q = j - 8;  J.W = ap->in[IN_XA_WQ] + (size_t)q * DM * DM; J.K = DM; J.N = DM; J.ldw = DM; J.dst = (bf16_t*)(ws + W_XA_Q) + (size_t)q * DM * DM; lnidx = q * 3 + 0; cv = CV_XAQ + q * DM; }
    else if (j < 16) { const int q = j - 12; J.W = ap->in[IN_XA_WKV] + (size_t)q * DM * 4096; J.K = DM; J.N = DM; J.ldw = 4096; J.dst = (bf16_t*)(ws + S_WKT) + (size_t)q * DM * DM; }
    else if (j < 20) { const int q = j - 16; J.W = ap->in[IN_XA_WKV] + (size_t)q * DM * 4096 + 2048; J.K = DM; J.N = DM; J.ldw = 4096; J.dst = (bf16_t*)(ws + S_WVT) + (size_t)q * DM * DM; }
    else if (j < 24) { const int q = j - 20; J.W = ap->in[IN_XA_WOUT] + (size_t)q * DM * DM; J.K = DM; J.N = DM; J.ldw = DM; J.dst = (bf16_t*)(ws + W_XA_OUT) + (size_t)q * DM * DM; }
    else if (j < 28) { const int q = j - 24; J.W = ap->in[IN_W1] + (size_t)q * DM * DFF; J.K = DM; J.N = DFF; J.ldw = DFF; J.dst = (bf16_t*)(ws + W_W1) + (size_t)q * DFF * DM; lnidx = q * 3 + 1; cv = CV_W1 + q * DFF; }
    else             { const int q = j - 28; J.W = ap->in[IN_W2] + (size_t)q * DFF * DM; J.K = DFF; J.N = DM; J.ldw = DM; J.dst = (bf16_t*)(ws + W_W2) + (size_t)q * DM * DFF; }
    if (lnidx >= 0) { J.g = lng + lnidx * DM; J.b = lnb + lnidx * DM; J.cpart = cp + (size_t)cv * 32; }
}
constexpr int N_TJOBS = 32;
__host__ __device__ __forceinline__ int qk_slot(int n) {
    if (n >= 2560) return n;
    const int e = n & 127, sec = e >> 6, w6 = e & 63, half = w6 >> 5, x1 = w6 & 31;
    return (n & ~127) | ((sec * 2 + (x1 >> 4)) << 5) | (((x1 >> 2) & 3) << 3) | (half << 2) | (x1 & 3);
}
__device__ __forceinline__ void transpose_item(const TJob& J, LAS float* scr, int item, int lane) {
    const int nblk = J.N / 32, kb = item / nblk, nb = item % nblk, k0 = 64 * kb, n0 = 32 * nb;
#pragma unroll
    for (int i = 0; i < 8; ++i) { const int kk = 8 * i + (lane >> 3), c4 = (lane & 7) * 4; const f32x4 v = *(const f32x4*)(J.W + (size_t)(k0 + kk) * J.ldw + n0 + c4);
        LAS float* d = scr + kk * 33 + c4; d[0] = v[0]; d[1] = v[1]; d[2] = v[2]; d[3] = v[3]; }
    LDS_WAIT(); asm volatile("" ::: "memory");
    const int c = lane & 7;
    float gk[8], bk[8];
    const bool fold = (J.g != nullptr);
#pragma unroll
    for (int i = 0; i < 8; ++i) { gk[i] = fold ? J.g[k0 + 8 * c + i] : 1.f; bk[i] = fold ? J.b[k0 + 8 * c + i] : 0.f; }
#pragma unroll
    for (int j = 0; j < 4; ++j) { const int n = (lane >> 3) + 8 * j; const LAS float* s = scr + (8 * c) * 33 + n;
        unsigned bits[8]; float c1p = 0.f, c2p = 0.f;
#pragma unroll
        for (int i = 0; i < 8; ++i) { const float w = s[i * 33]; bits[i] = f2bf(w * gk[i]); c1p += bf2f(bits[i]); c2p += bk[i] * w; }
        u32x4 o; o.x = bits[0] | (bits[1] << 16); o.y = bits[2] | (bits[3] << 16); o.z = bits[4] | (bits[5] << 16); o.w = bits[6] | (bits[7] << 16);
        const int drow = J.qkperm ? qk_slot(n0 + n) : n0 + n;
        *(u32x4*)(J.dst + (size_t)drow * J.K + k0 + 8 * c) = o;
        if (fold) {
            c1p = sum8(c1p); c2p = sum8(c2p);
            if (c == 0) J.cpart[(size_t)kb * J.N + drow] = (f32x2){c1p, c2p}; } }
    LDS_WAIT(); asm volatile("" ::: "memory");
}
__device__ __forceinline__ void convert_item(const TJob& J, int item, int lane) {
    const int nblk = J.N / 128, kb = item / nblk, nb = item % nblk, k0 = 64 * kb, n0 = 128 * nb + 2 * lane;
    float c1a = 0.f, c1b = 0.f, c2a = 0.f, c2b = 0.f;
#pragma unroll 8
    for (int k = 0; k < 64; ++k) { const f32x2 wv = *(const f32x2*)(J.W + (size_t)(k0 + k) * J.ldw + n0); const float gk = J.g ? J.g[k0 + k] : 1.f, bk = J.b ? J.b[k0 + k] : 0.f;
        const unsigned ba = f2bf(wv.x * gk), bb = f2bf(wv.y * gk); *(unsigned*)(J.dst + (size_t)(k0 + k) * J.N + n0) = ba | (bb << 16);
        c1a += bf2f(ba); c1b += bf2f(bb); c2a += bk * wv.x; c2b += bk * wv.y; }
    if (J.cpart) { J.cpart[(size_t)kb * J.N + n0] = (f32x2){c1a, c2a}; J.cpart[(size_t)kb * J.N + n0 + 1] = (f32x2){c1b, c2b}; }
}
__device__ __forceinline__ void cvt_rows(const float* src, bf16_t* dst, size_t n8, size_t gtid, size_t gthreads) {
    for (size_t i = gtid; i < n8; i += gthreads) { const f32x4 a = *(const f32x4*)(src + i * 8), b = *(const f32x4*)(src + i * 8 + 4);
        u32x4 w; w.x = cvt_pk_bf16(a[0], a[1]); w.y = cvt_pk_bf16(a[2], a[3]); w.z = cvt_pk_bf16(b[0], b[1]); w.w = cvt_pk_bf16(b[2], b[3]); *(u32x4*)(dst + i * 8) = w; }
}

__device__ __forceinline__ void cvt_rows_tiled(const float* src, bf16_t* dst, size_t n8, size_t gtid, size_t gthreads) {
    for (size_t i0 = gtid; i0 < n8; i0 += 4 * gthreads) { f32x4 a[4], b[4];
#pragma unroll
        for (int q = 0; q < 4; ++q) { const size_t i = i0 + q * gthreads, blk = i >> 6; const int w = (int)(i & 63), rl = w >> 2, c8 = (w & 3) * 8;
            const size_t rb = blk / (DM / 32); const int cb = (int)(blk % (DM / 32)); const float* s = src + (rb * 16 + rl) * DM + cb * 32 + c8;
            a[q] = *(const f32x4*)s; b[q] = *(const f32x4*)(s + 4); }
#pragma unroll
        for (int q = 0; q < 4; ++q) { const size_t i = i0 + q * gthreads;
            u32x4 wv; wv.x = cvt_pk_bf16(a[q][0], a[q][1]); wv.y = cvt_pk_bf16(a[q][2], a[q][3]); wv.z = cvt_pk_bf16(b[q][0], b[q][1]); wv.w = cvt_pk_bf16(b[q][2], b[q][3]); *(u32x4*)(dst + i * 8) = wv; } }
}

constexpr int SC_T = 16;
constexpr int SC_BUF = SC_T * 128 * 4 * 2 + SC_T * 64 * 4 + SC_T * 8 + SC_T * 64 * 4;
__device__ __forceinline__ void scan_item(const bf16_t* __restrict__ hq, const bf16_t* __restrict__ hk, const bf16_t* __restrict__ hv, const float* __restrict__ gi, const float* __restrict__ gf,
                                          float* __restrict__ hout, int S, int dir, char* lds) {
    const int tid = opaque_tid(), dv = tid >> 3, part = tid & 7, sub = dv & 7;
    float C[16]; float n0 = 0.f, n1 = 0.f, m = 0.f;
#pragma unroll
    for (int i = 0; i < 16; ++i) C[i] = 0.f;
    const int nblk = S / SC_T;
    const int ra = (tid & 255) >> 4, ca = tid & 15; const bool isk = tid >= 256;
    const int rb = tid >> 3, cb = tid & 7;
    bf16x8 sa, sb; float sgi = 0.f, sgf = 0.f;
#define SC_POS(blk, t) (dir ? (S - 1 - ((blk) * SC_T + (t))) : ((blk) * SC_T + (t)))
#define SC_LOAD(blk) do { { const long p = SC_POS(blk, ra); sa = *(const bf16x8*)((isk ? hk : hq) + p * ML_MAIN + ca * 8); } \
        if (tid < 128) { const long p = SC_POS(blk, rb); sb = *(const bf16x8*)(hv + p * ML_MAIN + cb * 8); } \
        if (tid < SC_T) { const long p = SC_POS(blk, tid); sgi = gi[p * 32]; sgf = gf[p * 32]; } } while (0)
#define SC_WRITE(buf) do { char* B_ = lds + (buf) * SC_BUF; float* dst_ = (float*)(B_ + (isk ? 8192 : 0)) + ra * 128 + ca * 8; const float sc_ = isk ? 0.088388347648318440f : 1.f; \
        f32x4 lo_, hi_; _Pragma("unroll") for (int e = 0; e < 4; ++e) { lo_[e] = bf2f((unsigned short)sa[e]) * sc_; hi_[e] = bf2f((unsigned short)sa[4 + e]) * sc_; } \
        *(f32x4*)dst_ = lo_; *(f32x4*)(dst_ + 4) = hi_; \
        if (tid < 128) { float* dv_ = (float*)(B_ + 16384) + rb * 64 + cb * 8; f32x4 l2_, h2_; _Pragma("unroll") for (int e = 0; e < 4; ++e) { l2_[e] = bf2f((unsigned short)sb[e]); h2_[e] = bf2f((unsigned short)sb[4 + e]); } \
            *(f32x4*)dv_ = l2_; *(f32x4*)(dv_ + 4) = h2_; } \
        if (tid < SC_T) { float* dg_ = (float*)(B_ + 16384 + 4096) + tid * 2; const float x_ = sgf; const float lf_ = fminf(x_, 0.f) - __logf(1.f + __expf(-fabsf(x_))); dg_[0] = sgi; dg_[1] = lf_; } } while (0)
    SC_LOAD(0); SC_WRITE(0); __syncthreads();
    for (int blk = 0; blk < nblk; ++blk) {
        const int cur = blk & 1;
        if (blk + 1 < nblk) SC_LOAD(blk + 1);
        const char* B = lds + cur * SC_BUF; const float* ql = (const float*)B; const float* kl = (const float*)(B + 8192); const float* vl = (const float*)(B + 16384); const float* gl = (const float*)(B + 16384 + 4096);
        float* hb = (float*)(B + 16384 + 4096 + 128);
#pragma unroll 2
        for (int t = 0; t < SC_T; ++t) {
            f32x4 q4[4], k4[4];
#pragma unroll
            for (int e = 0; e < 4; ++e) { q4[e] = *(const f32x4*)(ql + t * 128 + part * 16 + e * 4); k4[e] = *(const f32x4*)(kl + t * 128 + part * 16 + e * 4); }
            const f32x2 qn = *(const f32x2*)(ql + t * 128 + part * 16 + sub * 2), kn = *(const f32x2*)(kl + t * 128 + part * 16 + sub * 2);
            const float vt = vl[t * 64 + dv]; const float li = gl[t * 2], lf = gl[t * 2 + 1];
            const float mn = fmaxf(lf + m, li); const float fp = __expf(lf + m - mn), ip = __expf(li - mn); m = mn;
            const float iv = ip * vt; float hp = 0.f;
#pragma unroll
            for (int e = 0; e < 4; ++e)
#pragma unroll
                for (int x = 0; x < 4; ++x) { C[e * 4 + x] = fp * C[e * 4 + x] + iv * k4[e][x]; hp += C[e * 4 + x] * q4[e][x]; }
            n0 = fp * n0 + ip * kn.x; n1 = fp * n1 + ip * kn.y; float dp = n0 * qn.x + n1 * qn.y;
            hp += __shfl_xor(hp, 1); hp += __shfl_xor(hp, 2); hp += __shfl_xor(hp, 4);
            dp = wave_sum(dp);
            const float den = fmaxf(fabsf(dp), __expf(-m));
            if (part == 0) hb[t * 64 + dv] = hp / den;
        }
        if (blk + 1 < nblk) SC_WRITE(cur ^ 1);
        __syncthreads();
        if (tid < 256) { const int t = tid >> 4, c4 = tid & 15; const long p = SC_POS(blk, t); *(f32x4*)(hout + p * DM + c4 * 4) = *(const f32x4*)(hb + t * 64 + c4 * 4); }
    }
    __syncthreads();
#undef SC_POS
#undef SC_LOAD
#undef SC_WRITE
}

namespace ms {
constexpr int L_QS = 0, L_KS = 16384, L_KW = 32768, L_V = 49152, L_SB = 65536, L_CB = 81920, L_VEC = 98304, VEC_STRIDE = 1536;
constexpr int L_N = L_VEC + 2 * VEC_STRIDE, L_NQ = L_N + 512, L_DENP = L_NQ + 256, L_END = L_DENP + 512;
typedef short v4i16_t __attribute__((ext_vector_type(4)));
__device__ __forceinline__ unsigned offb(unsigned row, unsigned ch) { return 256u * row + 16u * (ch ^ (((row & 3) << 2) | ((row >> 2) & 3))); }
__device__ __forceinline__ bf16x8 rowfrag(LAS const unsigned char* img, int row, int kstep, int lane) { return *(const LAS bf16x8*)(img + offb(row, 4 * kstep + (lane >> 4))); }
__device__ __forceinline__ bf16x8 trfrag(LAS const unsigned char* img, int c, int ks, int lane) {
    const unsigned g = lane >> 4, q = (lane & 15) >> 2, p = lane & 3;
    const v4i16_t t0 = __builtin_amdgcn_ds_read_tr16_b64_v4i16((LAS v4i16_t*)(img + offb(32 * ks + 8 * g + q, 2 * c + (p >> 1)) + 8 * (p & 1)));
    const v4i16_t t1 = __builtin_amdgcn_ds_read_tr16_b64_v4i16((LAS v4i16_t*)(img + offb(32 * ks + 8 * g + 4 + q, 2 * c + (p >> 1)) + 8 * (p & 1)));
    return (bf16x8){t0[0], t0[1], t0[2], t0[3], t1[0], t1[1], t1[2], t1[3]};
}
__device__ __forceinline__ void scan_item(const bf16_t* __restrict__ hq, const bf16_t* __restrict__ hk, const bf16_t* __restrict__ hv, const float* __restrict__ gi, const float* __restrict__ gf,
                                          float* __restrict__ hout, int S, int dir, LAS unsigned char* L) {
    const int tid = opaque_tid(), lane = tid & 63, w = __builtin_amdgcn_readfirstlane(tid >> 6);
    const int nch = S >> 6;
    LAS unsigned char* Qs = L + L_QS; LAS unsigned char* Ks = L + L_KS; LAS unsigned char* Kw = L + L_KW; LAS unsigned char* Vi = L + L_V; LAS unsigned char* Sb = L + L_SB; LAS unsigned char* Cb = L + L_CB;
    LAS float* nv = (LAS float*)(L + L_N); LAS float* nq = (LAS float*)(L + L_NQ); LAS float* denp = (LAS float*)(L + L_DENP);
    f32x4 Cacc[4];
#pragma unroll
    for (int i = 0; i < 4; ++i) Cacc[i] = (f32x4){0.f, 0.f, 0.f, 0.f};
    float m = 0.f;
    { const u32x4 zz = {0u, 0u, 0u, 0u}; *(LAS u32x4*)(Cb + tid * 32) = zz; *(LAS u32x4*)(Cb + tid * 32 + 16) = zz; if (tid < 128) nv[tid] = 0.f; }
    bf16x8 rq[2], rk[2], rv; float rgi = 0.f, rgf = 0.f;
#define MS_POS(j, row) (dir ? (S - 1 - ((j) * 64 + (row))) : ((j) * 64 + (row)))
#define MS_LOAD(j) do { _Pragma("unroll") for (int i_ = 0; i_ < 2; ++i_) { const int pi_ = tid + 512 * i_; const long p_ = MS_POS(j, pi_ >> 4); \
            rq[i_] = *(const bf16x8*)(hq + p_ * ML_MAIN + (pi_ & 15) * 8); rk[i_] = *(const bf16x8*)(hk + p_ * ML_MAIN + (pi_ & 15) * 8); } \
        { const long p_ = MS_POS(j, tid >> 3); rv = *(const bf16x8*)(hv + p_ * ML_MAIN + (tid & 7) * 8); } \
        if (w == 0) { const long p_ = MS_POS(j, lane); rgi = gi[p_ * 32]; rgf = gf[p_ * 32]; } } while (0)
#define MS_VEC(vb) do { if (w == 0) { LAS float* V_ = (LAS float*)(L + L_VEC + (vb) * VEC_STRIDE); const float xf_ = rgf; const float lf_ = fminf(xf_, 0.f) - __logf(1.f + __expf(-fabsf(xf_))); \
        const float b_ = scan_add(lf_); const float a_ = rgi - b_; const float pm_ = scan_max(a_); \
        const float M_ = fmaxf(m, pm_); const float M63_ = __int_as_float(__builtin_amdgcn_readlane(__float_as_int(M_), 63)), bL_ = __int_as_float(__builtin_amdgcn_readlane(__float_as_int(b_), 63)); \
        V_[lane] = a_; V_[64 + lane] = M_; V_[128 + lane] = __expf(m - M_); V_[192 + lane] = __expf(-(b_ + M_)); V_[256 + lane] = __expf(a_ - M63_); if (lane == 0) V_[320] = __expf(m - M63_); \
        m = bL_ + M63_; } } while (0)
#define MS_STAGE(vb) do { LAS const float* V_ = (LAS const float*)(L + L_VEC + (vb) * VEC_STRIDE); \
        _Pragma("unroll") for (int i_ = 0; i_ < 2; ++i_) { const int pi_ = tid + 512 * i_, row_ = pi_ >> 4, ch_ = pi_ & 15; const unsigned o_ = offb(row_, ch_); \
            *(LAS bf16x8*)(Qs + o_) = rq[i_]; const float ws_ = V_[256 + row_]; u32x4 k0_, k1_; \
            float kf_[8]; _Pragma("unroll") for (int e_ = 0; e_ < 8; ++e_) kf_[e_] = bf2f((unsigned short)rk[i_][e_]) * 0.088388347648318440f; \
            k0_.x = cvt_pk_bf16(kf_[0], kf_[1]); k0_.y = cvt_pk_bf16(kf_[2], kf_[3]); k0_.z = cvt_pk_bf16(kf_[4], kf_[5]); k0_.w = cvt_pk_bf16(kf_[6], kf_[7]); \
            k1_.x = cvt_pk_bf16(kf_[0] * ws_, kf_[1] * ws_); k1_.y = cvt_pk_bf16(kf_[2] * ws_, kf_[3] * ws_); k1_.z = cvt_pk_bf16(kf_[4] * ws_, kf_[5] * ws_); k1_.w = cvt_pk_bf16(kf_[6] * ws_, kf_[7] * ws_); \
            *(LAS u32x4*)(Ks + o_) = k0_; *(LAS u32x4*)(Kw + o_) = k1_; } \
        *(LAS bf16x8*)(Vi + offb(tid >> 3, tid & 7)) = rv; } while (0)
    MS_LOAD(0); MS_VEC(0);
    __syncthreads();
    MS_STAGE(0);
    const int tl = w >> 1, th = w & 1, lr = lane & 15, lg = lane >> 4;
    for (int j = 0; j < nch; ++j) {
        const int vb = j & 1;
        LAS const float* V = (LAS const float*)(L + L_VEC + vb * VEC_STRIDE);
        __syncthreads();
        if (j + 1 < nch) MS_LOAD(j + 1);
        { const int l = tid >> 3, part = tid & 7;
          const bf16x8 q0 = *(const LAS bf16x8*)(Qs + offb(l, 2 * part)), q1 = *(const LAS bf16x8*)(Qs + offb(l, 2 * part + 1));
          float s = 0.f;
#pragma unroll
          for (int e = 0; e < 8; ++e) { s += bf2f((unsigned short)q0[e]) * nv[part * 16 + e]; s += bf2f((unsigned short)q1[e]) * nv[part * 16 + 8 + e]; }
          s = sum8(s);
          if (part == 0) nq[l] = s; }
        bf16x8 qf[4];
#pragma unroll
        for (int kk = 0; kk < 4; ++kk) qf[kk] = rowfrag(Qs, 16 * tl + lr, kk, lane);
        f32x4 acc3[2];
        { const int l = 16 * tl + lr; const float Ml = V[64 + l]; float rs = 0.f;
#pragma unroll
          for (int i = 0; i < 2; ++i) { const int ts = 2 * th + i; f32x4 sv = {0.f, 0.f, 0.f, 0.f};
              if (ts <= tl) { f32x4 acc = {0.f, 0.f, 0.f, 0.f};
#pragma unroll
                  for (int kk = 0; kk < 4; ++kk) acc = __builtin_amdgcn_mfma_f32_16x16x32_bf16(rowfrag(Ks, 16 * ts + lr, kk, lane), qf[kk], acc, 0, 0, 0);
                  const f32x4 a4 = *(const LAS f32x4*)(V + 16 * ts + 4 * lg);
#pragma unroll
                  for (int r = 0; r < 4; ++r) { const int s = 16 * ts + 4 * lg + r; sv[r] = (s <= l) ? acc[r] * __expf(a4[r] - Ml) : 0.f; } }
              u32x2 pk; pk.x = cvt_pk_bf16(sv[0], sv[1]); pk.y = cvt_pk_bf16(sv[2], sv[3]);
              const int s0 = 16 * ts + 4 * lg; *(LAS u32x2*)(Sb + offb(l, s0 >> 3) + 2 * (s0 & 7)) = pk;
              rs += (sv[0] + sv[1]) + (sv[2] + sv[3]); }
          rs = sum_x32(sum_x16(rs));
          if (lane < 16) denp[l * 2 + th] = rs; }
#pragma unroll
        for (int i = 0; i < 2; ++i) { const int tdv = 2 * th + i; f32x4 acc = {0.f, 0.f, 0.f, 0.f};
#pragma unroll
            for (int kk = 0; kk < 4; ++kk) acc = __builtin_amdgcn_mfma_f32_16x16x32_bf16(qf[kk], rowfrag(Cb, 16 * tdv + lr, kk, lane), acc, 0, 0, 0);
            acc3[i] = acc; }
        __syncthreads();
        bf16x8 vf[4][2];
#pragma unroll
        for (int c = 0; c < 4; ++c)
#pragma unroll
            for (int ks = 0; ks < 2; ++ks) vf[c][ks] = trfrag(Vi, c, ks, lane);
        { const int l0 = 16 * tl + 4 * lg;
          const f32x4 g4 = *(const LAS f32x4*)(V + 128 + l0), fl4 = *(const LAS f32x4*)(V + 192 + l0), nq4 = *(const LAS f32x4*)(nq + l0);
          const f32x4 dp0 = *(const LAS f32x4*)(denp + l0 * 2), dp1 = *(const LAS f32x4*)(denp + l0 * 2 + 4);
          f32x4 inv;
          inv[0] = __builtin_amdgcn_rcpf(fmaxf(fabsf(g4[0] * nq4[0] + dp0[0] + dp0[1]), fl4[0])); inv[1] = __builtin_amdgcn_rcpf(fmaxf(fabsf(g4[1] * nq4[1] + dp0[2] + dp0[3]), fl4[1]));
          inv[2] = __builtin_amdgcn_rcpf(fmaxf(fabsf(g4[2] * nq4[2] + dp1[0] + dp1[1]), fl4[2])); inv[3] = __builtin_amdgcn_rcpf(fmaxf(fabsf(g4[3] * nq4[3] + dp1[2] + dp1[3]), fl4[3]));
          const bf16x8 sf0 = rowfrag(Sb, 16 * tl + lr, 0, lane), sf1 = rowfrag(Sb, 16 * tl + lr, 1, lane);
#pragma unroll
          for (int i = 0; i < 2; ++i) { const int tdv = 2 * th + i; f32x4 acc = acc3[i] * g4;
              acc = __builtin_amdgcn_mfma_f32_16x16x32_bf16(sf0, trfrag(Vi, tdv, 0, lane), acc, 0, 0, 0);
              acc = __builtin_amdgcn_mfma_f32_16x16x32_bf16(sf1, trfrag(Vi, tdv, 1, lane), acc, 0, 0, 0);
#pragma unroll
              for (int r = 0; r < 4; ++r) { const long p = MS_POS(j, l0 + r); hout[p * DM + 16 * tdv + lr] = acc[r] * inv[r]; } } }
        { const float gs = V[320];
          const bf16x8 ak0 = trfrag(Kw, w, 0, lane), ak1 = trfrag(Kw, w, 1, lane);
#pragma unroll
          for (int c = 0; c < 4; ++c) { f32x4 acc = Cacc[c] * gs;
              acc = __builtin_amdgcn_mfma_f32_16x16x32_bf16(ak0, vf[c][0], acc, 0, 0, 0);
              acc = __builtin_amdgcn_mfma_f32_16x16x32_bf16(ak1, vf[c][1], acc, 0, 0, 0);
              Cacc[c] = acc;
              u32x2 pk; pk.x = cvt_pk_bf16(acc[0], acc[1]); pk.y = cvt_pk_bf16(acc[2], acc[3]);
              const int dk0 = 16 * w + 4 * lg; *(LAS u32x2*)(Cb + offb(16 * c + lr, dk0 >> 3) + 2 * (dk0 & 7)) = pk; }
          if (tid < 128) { float a = gs * nv[tid];
#pragma unroll 8
              for (int s = 0; s < 64; ++s) a += bf2f(*(const LAS unsigned short*)(Kw + offb(s, tid >> 3) + 2 * (tid & 7)));
              nv[tid] = a; } }
        if (j + 1 < nch) MS_VEC(vb ^ 1);
        __syncthreads();
        if (j + 1 < nch) MS_STAGE(vb ^ 1);
    }
    __syncthreads();
#undef MS_POS
#undef MS_LOAD
#undef MS_VEC
#undef MS_STAGE
}
}

namespace ms2 {
using ms::offb; using ms::rowfrag; using ms::trfrag; using ms::v4i16_t;
constexpr int IMG = 16384, L_QS = 0, L_KW = 2 * IMG, L_V = 4 * IMG, L_CB = 6 * IMG;
constexpr int L_NV = LDS_XL, L_TAB = LDS_XL + 1024, L_SCR = LDS_XL + 2048;
__device__ __forceinline__ float bperm(float v, int srclane) { return __int_as_float(__builtin_amdgcn_ds_bpermute(srclane << 2, __float_as_int(v))); }
__device__ __forceinline__ bf16x8 trfrag_perm(LAS const unsigned char* img, int c, int ks, int lane) {
    const unsigned g = lane >> 4, q = (lane & 15) >> 2, p = lane & 3;
    const v4i16_t t0 = __builtin_amdgcn_ds_read_tr16_b64_v4i16((LAS v4i16_t*)(img + offb(32 * ks + 4 * g + q, 2 * c + (p >> 1)) + 8 * (p & 1)));
    const v4i16_t t1 = __builtin_amdgcn_ds_read_tr16_b64_v4i16((LAS v4i16_t*)(img + offb(32 * ks + 16 + 4 * g + q, 2 * c + (p >> 1)) + 8 * (p & 1)));
    return (bf16x8){t0[0], t0[1], t0[2], t0[3], t1[0], t1[1], t1[2], t1[3]};
}
__device__ __forceinline__ float logsig(float x) { return fminf(x, 0.f) - __logf(1.f + __expf(-fabsf(x))); }
__device__ __forceinline__ void scan_item(const bf16_t* __restrict__ hq, const bf16_t* __restrict__ hk, const bf16_t* __restrict__ hv, const float* __restrict__ gi, const float* __restrict__ gf,
                                          float* __restrict__ hout, int S, int dir, LAS unsigned char* L) {
    const int tid = opaque_tid(), lane = tid & 63, w = __builtin_amdgcn_readfirstlane(tid >> 6);
    const int nch = S >> 6, tl = w >> 1, th = w & 1, lr = lane & 15, lg = lane >> 4;
    LAS float* nvb = (LAS float*)(L + L_NV); LAS float* bLt = (LAS float*)(L + L_TAB); LAS float* pmLt = bLt + 64; LAS float* mtab = bLt + 128; LAS float* scr = (LAS float*)(L + L_SCR) + w * 16;
#define MS_POS(j, row) (dir ? (S - 1 - ((j) * 64 + (row))) : ((j) * 64 + (row)))
    { const u32x4 zz = {0u, 0u, 0u, 0u}; *(LAS u32x4*)(L + L_CB + tid * 32) = zz; *(LAS u32x4*)(L + L_CB + tid * 32 + 16) = zz; if (tid < 128) nvb[tid] = 0.f; }
    for (int c = w; c < nch; c += 8) { const long p = MS_POS(c, lane); const float li = gi[p * 32], lf = logsig(gf[p * 32]);
        const float b = scan_add(lf), pm = scan_max(li - b); if (lane == 63) { bLt[c] = b; pmLt[c] = pm; } }
    __syncthreads();
    if (tid == 0) { float m = 0.f; for (int c = 0; c < nch; ++c) { mtab[c] = m; m = bLt[c] + fmaxf(m, pmLt[c]); } }
    __syncthreads();
    f32x4 Cacc[4], nacc = {0.f, 0.f, 0.f, 0.f};
#pragma unroll
    for (int i = 0; i < 4; ++i) Cacc[i] = (f32x4){0.f, 0.f, 0.f, 0.f};
    const bf16x8 ones = {0x3F80, 0x3F80, 0x3F80, 0x3F80, 0x3F80, 0x3F80, 0x3F80, 0x3F80};
    bf16x8 rqA[2], rkA[2], rvA; float rgiA, rgfA;
    float va, vb, vpm;
#define MS_LOAD(j, X) do { _Pragma("unroll") for (int i_ = 0; i_ < 2; ++i_) { const int pi_ = tid + 512 * i_; const long p_ = MS_POS(j, pi_ >> 4); \
            rq##X[i_] = *(const bf16x8*)(hq + p_ * ML_MAIN + (pi_ & 15) * 8); rk##X[i_] = *(const bf16x8*)(hk + p_ * ML_MAIN + (pi_ & 15) * 8); } \
        { const long p_ = MS_POS(j, tid >> 3); rv##X = *(const bf16x8*)(hv + p_ * ML_MAIN + (tid & 7) * 8); } \
        { const long p_ = MS_POS(j, lane); rgi##X = gi[p_ * 32]; rgf##X = gf[p_ * 32]; } } while (0)
#define MS_STAGE(j, bf, X) do { { const float lf_ = logsig(rgf##X); vb = scan_add(lf_); va = rgi##X - vb; vpm = scan_max(va); } \
        const float M63_ = fmaxf(mtab[j], __int_as_float(__builtin_amdgcn_readlane(__float_as_int(vpm), 63))); const float wsl_ = __expf(va - M63_); \
        _Pragma("unroll") for (int i_ = 0; i_ < 2; ++i_) { const int pi_ = tid + 512 * i_, row_ = pi_ >> 4, ch_ = pi_ & 15; const unsigned o_ = offb(row_, ch_); \
            *(LAS bf16x8*)(L + L_QS + (bf) * IMG + o_) = rq##X[i_]; const float ws_ = bperm(wsl_, row_) * 0.088388347648318440f; u32x4 k1_; \
            float kf_[8]; _Pragma("unroll") for (int e_ = 0; e_ < 8; ++e_) kf_[e_] = bf2f((unsigned short)rk##X[i_][e_]) * ws_; \
            k1_.x = cvt_pk_bf16(kf_[0], kf_[1]); k1_.y = cvt_pk_bf16(kf_[2], kf_[3]); k1_.z = cvt_pk_bf16(kf_[4], kf_[5]); k1_.w = cvt_pk_bf16(kf_[6], kf_[7]); \
            *(LAS u32x4*)(L + L_KW + (bf) * IMG + o_) = k1_; } \
        *(LAS bf16x8*)(L + L_V + (bf) * IMG + offb(tid >> 3, tid & 7)) = rv##X; } while (0)
#define MS_SB() __builtin_amdgcn_sched_barrier(0)
#define MS_CHUNK(j) do { const int cur = (j) & 1, nxt = cur ^ 1; \
        LAS const unsigned char* Qs = L + L_QS + cur * IMG; LAS const unsigned char* Kw = L + L_KW + cur * IMG; LAS const unsigned char* Vi = L + L_V + cur * IMG; \
        LAS const unsigned char* Cbr = L + L_CB + cur * IMG; LAS unsigned char* Cbw = L + L_CB + nxt * IMG; LAS const float* nvr = nvb + cur * 128; LAS float* nvw = nvb + nxt * 128; \
        const float mt = mtab[j]; const float Mv = fmaxf(mt, vpm); const float M63 = __int_as_float(__builtin_amdgcn_readlane(__float_as_int(Mv), 63)); \
        const float Mcol = bperm(Mv, 16 * tl + lr), bcol = bperm(vb, 16 * tl + lr); \
        f32x4 m4; _Pragma("unroll") for (int r = 0; r < 4; ++r) m4[r] = bperm(Mv, 16 * tl + 4 * lg + r); \
          \
        bf16x8 qf[4], kwa[2][4]; f32x4 nn[8]; \
        _Pragma("unroll") for (int kk = 0; kk < 4; ++kk) qf[kk] = rowfrag(Qs, 16 * tl + lr, kk, lane); \
        _Pragma("unroll") for (int t = 0; t < 2; ++t) _Pragma("unroll") for (int kk = 0; kk < 4; ++kk) kwa[t][kk] = rowfrag(Kw, 16 * t + lr, kk, lane); \
        _Pragma("unroll") for (int kk = 0; kk < 4; ++kk) { nn[2 * kk] = *(const LAS f32x4*)(nvr + 32 * kk + 8 * lg); nn[2 * kk + 1] = *(const LAS f32x4*)(nvr + 32 * kk + 8 * lg + 4); } \
        MS_SB(); \
        const float colscale = __expf(M63 - Mcol), gs = __expf(mt - M63); \
        f32x4 g4; _Pragma("unroll") for (int r = 0; r < 4; ++r) g4[r] = __expf(mt - m4[r]); \
        f32x4 sacc[4]; \
        _Pragma("unroll") for (int t = 0; t < 2; ++t) { f32x4 acc = {0.f, 0.f, 0.f, 0.f}; \
            _Pragma("unroll") for (int kk = 0; kk < 4; ++kk) acc = __builtin_amdgcn_mfma_f32_16x16x32_bf16(kwa[t][kk], qf[kk], acc, 0, 0, 0); sacc[t] = acc; } \
        MS_SB(); \
          \
        bf16x8 kwb[2][4], cbf[2][4]; \
        _Pragma("unroll") for (int t = 0; t < 2; ++t) _Pragma("unroll") for (int kk = 0; kk < 4; ++kk) kwb[t][kk] = rowfrag(Kw, 32 + 16 * t + lr, kk, lane); \
        _Pragma("unroll") for (int i = 0; i < 2; ++i) _Pragma("unroll") for (int kk = 0; kk < 4; ++kk) cbf[i][kk] = rowfrag(Cbr, 16 * (2 * th + i) + lr, kk, lane); \
        MS_SB(); \
        float nqp = 0.f; \
        _Pragma("unroll") for (int kk = 0; kk < 4; ++kk) _Pragma("unroll") for (int e = 0; e < 4; ++e) { nqp += bf2f((unsigned short)qf[kk][e]) * nn[2 * kk][e]; nqp += bf2f((unsigned short)qf[kk][4 + e]) * nn[2 * kk + 1][e]; } \
        nqp = sum_x32(sum_x16(nqp)); \
        _Pragma("unroll") for (int t = 0; t < 2; ++t) { f32x4 acc = {0.f, 0.f, 0.f, 0.f}; \
            _Pragma("unroll") for (int kk = 0; kk < 4; ++kk) acc = __builtin_amdgcn_mfma_f32_16x16x32_bf16(kwb[t][kk], qf[kk], acc, 0, 0, 0); sacc[2 + t] = acc; } \
        f32x4 acc3[2]; \
        _Pragma("unroll") for (int i = 0; i < 2; ++i) { f32x4 acc = {0.f, 0.f, 0.f, 0.f}; \
            _Pragma("unroll") for (int kk = 0; kk < 4; ++kk) acc = __builtin_amdgcn_mfma_f32_16x16x32_bf16(qf[kk], cbf[i][kk], acc, 0, 0, 0); acc3[i] = acc * g4; } \
        MS_SB(); \
          \
        bf16x8 vp[2][2]; \
        _Pragma("unroll") for (int i = 0; i < 2; ++i) _Pragma("unroll") for (int ks = 0; ks < 2; ++ks) vp[i][ks] = trfrag_perm(Vi, 2 * th + i, ks, lane); \
        MS_SB(); \
          \
        u32x2 spk[4]; float rs = 0.f; const int l = 16 * tl + lr; \
        _Pragma("unroll") for (int ts = 0; ts < 4; ++ts) { f32x4 sv; \
            _Pragma("unroll") for (int r = 0; r < 4; ++r) { const int s = 16 * ts + 4 * lg + r; sv[r] = (s <= l) ? sacc[ts][r] * colscale : 0.f; } \
            spk[ts].x = cvt_pk_bf16(sv[0], sv[1]); spk[ts].y = cvt_pk_bf16(sv[2], sv[3]); rs += (sv[0] + sv[1]) + (sv[2] + sv[3]); } \
        rs = sum_x32(sum_x16(rs)); \
        { const float den = __expf(mt - Mcol) * nqp + rs; const float inv = __builtin_amdgcn_rcpf(fmaxf(fabsf(den), __expf(-(bcol + Mcol)))); if (lg == 0) scr[lr] = inv; } \
        const f32x4 inv4 = *(const LAS f32x4*)(scr + 4 * lg); \
        bf16x8 sf0, sf1; { u32x4 t0 = {spk[0].x, spk[0].y, spk[1].x, spk[1].y}, t1 = {spk[2].x, spk[2].y, spk[3].x, spk[3].y}; sf0 = __builtin_bit_cast(bf16x8, t0); sf1 = __builtin_bit_cast(bf16x8, t1); } \
        _Pragma("unroll") for (int i = 0; i < 2; ++i) { const int tdv = 2 * th + i; f32x4 acc = acc3[i]; \
            acc = __builtin_amdgcn_mfma_f32_16x16x32_bf16(sf0, vp[i][0], acc, 0, 0, 0); \
            acc = __builtin_amdgcn_mfma_f32_16x16x32_bf16(sf1, vp[i][1], acc, 0, 0, 0); \
            _Pragma("unroll") for (int r = 0; r < 4; ++r) { const long p = MS_POS(j, 16 * tl + 4 * lg + r); hout[p * DM + 16 * tdv + lr] = acc[r] * inv4[r]; } } \
        MS_SB(); \
        bf16x8 vf[4][2], ak[2]; \
        _Pragma("unroll") for (int c = 0; c < 4; ++c) _Pragma("unroll") for (int ks = 0; ks < 2; ++ks) vf[c][ks] = trfrag(Vi, c, ks, lane); \
        ak[0] = trfrag(Kw, w, 0, lane); ak[1] = trfrag(Kw, w, 1, lane); \
        MS_SB(); \
        _Pragma("unroll") for (int c = 0; c < 4; ++c) { f32x4 acc = Cacc[c] * gs; \
            acc = __builtin_amdgcn_mfma_f32_16x16x32_bf16(ak[0], vf[c][0], acc, 0, 0, 0); \
            acc = __builtin_amdgcn_mfma_f32_16x16x32_bf16(ak[1], vf[c][1], acc, 0, 0, 0); \
            Cacc[c] = acc; \
            u32x2 pk; pk.x = cvt_pk_bf16(acc[0], acc[1]); pk.y = cvt_pk_bf16(acc[2], acc[3]); \
            const int dk0 = 16 * w + 4 * lg; *(LAS u32x2*)(Cbw + offb(16 * c + lr, dk0 >> 3) + 2 * (dk0 & 7)) = pk; } \
        { f32x4 na = nacc * gs; na = __builtin_amdgcn_mfma_f32_16x16x32_bf16(ak[0], ones, na, 0, 0, 0); na = __builtin_amdgcn_mfma_f32_16x16x32_bf16(ak[1], ones, na, 0, 0, 0); nacc = na; \
          if (lr == 0) *(LAS f32x4*)(nvw + 16 * w + 4 * lg) = na; } } while (0)
    MS_LOAD(0, A); MS_STAGE(0, 0, A);
    __syncthreads();
    for (int j = 0; j < nch; ++j) {
        if (j + 1 < nch) MS_LOAD(j + 1, A);
        MS_CHUNK(j);
        if (j + 1 < nch) MS_STAGE(j + 1, (j + 1) & 1, A);
        __syncthreads();
    }
#undef MS_POS
#undef MS_LOAD
#undef MS_STAGE
#undef MS_CHUNK
#undef MS_SB
}
}

namespace ms3 {
using ms::offb; using ms::rowfrag; using ms::trfrag; using ms2::trfrag_perm; using ms2::bperm; using ms2::logsig;
constexpr int IMG = 16384, L_QS = 0, L_KW = 2 * IMG, L_V = 4 * IMG, L_CB = 6 * IMG;
constexpr int L_NB = LDS_XL, L_TAB = LDS_XL + 1024, L_SCR = LDS_XL + 2048;
__device__ __forceinline__ void scan_item(const bf16_t* __restrict__ hq, const bf16_t* __restrict__ hk, const bf16_t* __restrict__ hv, const float* __restrict__ gi, const float* __restrict__ gf,
                                          bf16_t* __restrict__ hout, int S, int dir, LAS unsigned char* L) {
    const int tid = opaque_tid(), lane = tid & 63, w = __builtin_amdgcn_readfirstlane(tid >> 6);
    const int nch = S >> 6, lr = lane & 15, lg = lane >> 4;
    LAS float* bLt = (LAS float*)(L + L_TAB); LAS float* pmLt = bLt + 64; LAS float* mtab = bLt + 128; LAS float* scr = (LAS float*)(L + L_SCR) + w * 16;
#define MS_POS(j, row) (dir ? (S - 1 - ((j) * 64 + (row))) : ((j) * 64 + (row)))
    { const u32x4 zz = {0u, 0u, 0u, 0u}; *(LAS u32x4*)(L + L_CB + tid * 32) = zz; *(LAS u32x4*)(L + L_CB + tid * 32 + 16) = zz; if (tid < 64) ((LAS unsigned*)(L + L_NB))[tid] = 0u; }
    bf16x8 rqA[2], rkA[2], rvA, rqB[2], rkB[2], rvB; float rgiA, rgfA, rgiB, rgfB;
#define MS_TOFF(p, cc) (((p) >> 4) * (long)((ML_MAIN >> 5) * 512) + ((p) & 15) * 32 + ((cc) >> 5) * 512 + ((cc) & 31))
#define MS_LOAD(j, X) do { _Pragma("unroll") for (int i_ = 0; i_ < 2; ++i_) { const int pi_ = tid + 512 * i_; const long p_ = MS_POS(j, pi_ >> 4); \
            const long o_ = MS_TOFF(p_, (pi_ & 15) * 8); rq##X[i_] = *(const bf16x8*)(hq + o_); rk##X[i_] = *(const bf16x8*)(hk + o_); } \
        { const long p_ = MS_POS(j, tid >> 3); rv##X = *(const bf16x8*)(hv + MS_TOFF(p_, (tid & 7) * 8)); } \
        { const long p_ = MS_POS(j, lane); rgi##X = gi[p_]; rgf##X = gf[p_]; } } while (0)
    MS_LOAD(0, A);
    { float pli[8], plf[8];
#pragma unroll
      for (int i = 0; i < 8; ++i) { const int c = w + 8 * i; if (c < nch) { const long p = MS_POS(c, lane); pli[i] = gi[p]; plf[i] = gf[p]; } else { pli[i] = 0.f; plf[i] = 0.f; } }
#pragma unroll
      for (int i = 0; i < 8; ++i) { const int c = w + 8 * i; if (c < nch) { const float lf = logsig(plf[i]); const float b = scan_add(lf), pm = scan_max(pli[i] - b); if (lane == 63) { bLt[c] = b; pmLt[c] = pm; } } } }
    __syncthreads();
    if (tid == 0) { float m = 0.f; for (int c = 0; c < nch; ++c) { mtab[c] = m; m = bLt[c] + fmaxf(m, pmLt[c]); } }
    __syncthreads();
    f32x4 Cacc[2][4], nacc[2];
#pragma unroll
    for (int t = 0; t < 2; ++t) { nacc[t] = (f32x4){0.f, 0.f, 0.f, 0.f};
#pragma unroll
        for (int i = 0; i < 4; ++i) Cacc[t][i] = (f32x4){0.f, 0.f, 0.f, 0.f}; }
    const bf16x8 ones = {0x3F80, 0x3F80, 0x3F80, 0x3F80, 0x3F80, 0x3F80, 0x3F80, 0x3F80};
    float va, vb, vpm;
#define MS_STAGE(j, bf, X) do { { const float lf_ = logsig(rgf##X); vb = scan_add(lf_); va = rgi##X - vb; vpm = scan_max(va); } \
        const float M63_ = fmaxf(mtab[j], __int_as_float(__builtin_amdgcn_readlane(__float_as_int(vpm), 63))); const float wsl_ = __expf(va - M63_); \
        _Pragma("unroll") for (int i_ = 0; i_ < 2; ++i_) { const int pi_ = tid + 512 * i_, row_ = pi_ >> 4, ch_ = pi_ & 15; const unsigned o_ = offb(row_, ch_); \
            *(LAS bf16x8*)(L + L_QS + (bf) * IMG + o_) = rq##X[i_]; const float ws_ = bperm(wsl_, row_) * 0.088388347648318440f; u32x4 k1_; \
            float kf_[8]; _Pragma("unroll") for (int e_ = 0; e_ < 8; ++e_) kf_[e_] = bf2f((unsigned short)rk##X[i_][e_]) * ws_; \
            k1_.x = cvt_pk_bf16(kf_[0], kf_[1]); k1_.y = cvt_pk_bf16(kf_[2], kf_[3]); k1_.z = cvt_pk_bf16(kf_[4], kf_[5]); k1_.w = cvt_pk_bf16(kf_[6], kf_[7]); \
            *(LAS u32x4*)(L + L_KW + (bf) * IMG + o_) = k1_; } \
        *(LAS bf16x8*)(L + L_V + (bf) * IMG + offb(tid >> 3, tid & 7)) = rv##X; } while (0)
#define MS_SB() __builtin_amdgcn_sched_barrier(0)
    MS_STAGE(0, 0, A); MS_LOAD(1, A);
    __syncthreads();
    auto chunk = [&](const int j) __attribute__((always_inline)) {
        const int cur = j & 1, nxt = cur ^ 1;
        LAS const unsigned char* Qs = L + L_QS + cur * IMG; LAS const unsigned char* Kw = L + L_KW + cur * IMG; LAS const unsigned char* Vi = L + L_V + cur * IMG;
        LAS const unsigned char* Cbr = L + L_CB + cur * IMG; LAS unsigned char* Cbw = L + L_CB + nxt * IMG;
        LAS const unsigned char* nbr = L + L_NB + cur * 256; LAS unsigned char* nbw = L + L_NB + nxt * 256;
        const float mt = mtab[j]; const float Mv = fmaxf(mt, vpm); const float M63 = __int_as_float(__builtin_amdgcn_readlane(__float_as_int(Mv), 63));
        if (w < 4) {
            const int tl = w, l = 16 * tl + lr;
            const float Mcol = bperm(Mv, l), bcol = bperm(vb, l);
            bf16x8 qf[4], kwa[2][4], nbv[4];
#pragma unroll
            for (int kk = 0; kk < 4; ++kk) qf[kk] = rowfrag(Qs, l, kk, lane);
#pragma unroll
            for (int t = 0; t < 2; ++t)
#pragma unroll
                for (int kk = 0; kk < 4; ++kk) kwa[t][kk] = rowfrag(Kw, 16 * t + lr, kk, lane);
#pragma unroll
            for (int kk = 0; kk < 4; ++kk) nbv[kk] = *(const LAS bf16x8*)(nbr + (32 * kk + 8 * lg) * 2);
            MS_SB();
            const float colscale = __expf(M63 - Mcol), gcol = __expf(mt - Mcol);
            f32x4 sacc[4];
#pragma unroll
            for (int t = 0; t < 2; ++t) { f32x4 acc = {0.f, 0.f, 0.f, 0.f};
#pragma unroll
                for (int kk = 0; kk < 4; ++kk) acc = __builtin_amdgcn_mfma_f32_16x16x32_bf16(kwa[t][kk], qf[kk], acc, 0, 0, 0);
                sacc[t] = acc; }
            MS_SB();
            bf16x8 kwb[2][4], cbf[2][4];
#pragma unroll
            for (int t = 0; t < 2; ++t)
#pragma unroll
                for (int kk = 0; kk < 4; ++kk) { kwb[t][kk] = rowfrag(Kw, 32 + 16 * t + lr, kk, lane); cbf[t][kk] = rowfrag(Cbr, 16 * t + lr, kk, lane); }
            MS_SB();
            float nqp = 0.f;
#pragma unroll
            for (int kk = 0; kk < 4; ++kk)
#pragma unroll
                for (int e = 0; e < 8; ++e) nqp += bf2f((unsigned short)qf[kk][e]) * bf2f((unsigned short)nbv[kk][e]);
            nqp = sum_x32(sum_x16(nqp));
#pragma unroll
            for (int t = 0; t < 2; ++t) { f32x4 acc = {0.f, 0.f, 0.f, 0.f};
#pragma unroll
                for (int kk = 0; kk < 4; ++kk) acc = __builtin_amdgcn_mfma_f32_16x16x32_bf16(kwb[t][kk], qf[kk], acc, 0, 0, 0);
                sacc[2 + t] = acc; }
            f32x4 acc3[4];
#pragma unroll
            for (int t = 0; t < 2; ++t) { f32x4 acc = {0.f, 0.f, 0.f, 0.f};
#pragma unroll
                for (int kk = 0; kk < 4; ++kk) acc = __builtin_amdgcn_mfma_f32_16x16x32_bf16(cbf[t][kk], qf[kk], acc, 0, 0, 0);
                acc3[t] = acc * gcol; }
            MS_SB();
            bf16x8 cbg[2][4], vp[2][2];
#pragma unroll
            for (int t = 0; t < 2; ++t) {
#pragma unroll
                for (int kk = 0; kk < 4; ++kk) cbg[t][kk] = rowfrag(Cbr, 32 + 16 * t + lr, kk, lane);
#pragma unroll
                for (int ks = 0; ks < 2; ++ks) vp[t][ks] = trfrag_perm(Vi, t, ks, lane); }
            MS_SB();
            u32x2 spk[4]; float rs = 0.f;
#pragma unroll
            for (int ts = 0; ts < 4; ++ts) { f32x4 sv;
#pragma unroll
                for (int r = 0; r < 4; ++r) { const int s = 16 * ts + 4 * lg + r; sv[r] = (s <= l) ? sacc[ts][r] * colscale : 0.f; }
                spk[ts].x = cvt_pk_bf16(sv[0], sv[1]); spk[ts].y = cvt_pk_bf16(sv[2], sv[3]); rs += (sv[0] + sv[1]) + (sv[2] + sv[3]); }
            rs = sum_x32(sum_x16(rs));
            const float inv = __builtin_amdgcn_rcpf(fmaxf(fabsf(gcol * nqp + rs), __expf(-(bcol + Mcol))));
            bf16_t* const hrow = hout + (long)MS_POS(j, l) * DM + ((lg & 1) ? 16 + 4 * (lg - 1) : 4 * lg);
#define MS_HSTORE(p, pe, po) do { const auto rx_ = __builtin_amdgcn_permlane16_swap((pe).x, (po).x, false, false); const auto ry_ = __builtin_amdgcn_permlane16_swap((pe).y, (po).y, false, false); \
                const u32x4 w_ = {rx_[0], ry_[0], rx_[1], ry_[1]}; *(u32x4*)(hrow + 32 * (p)) = w_; } while (0)
            u32x2 hpk[2];
            bf16x8 sf0, sf1; { u32x4 t0 = {spk[0].x, spk[0].y, spk[1].x, spk[1].y}, t1 = {spk[2].x, spk[2].y, spk[3].x, spk[3].y}; sf0 = __builtin_bit_cast(bf16x8, t0); sf1 = __builtin_bit_cast(bf16x8, t1); }
#pragma unroll
            for (int t = 0; t < 2; ++t) { f32x4 acc = {0.f, 0.f, 0.f, 0.f};
#pragma unroll
                for (int kk = 0; kk < 4; ++kk) acc = __builtin_amdgcn_mfma_f32_16x16x32_bf16(cbg[t][kk], qf[kk], acc, 0, 0, 0);
                acc3[2 + t] = acc * gcol; }
#pragma unroll
            for (int t = 0; t < 2; ++t) { f32x4 acc = acc3[t];
                acc = __builtin_amdgcn_mfma_f32_16x16x32_bf16(vp[t][0], sf0, acc, 0, 0, 0);
                acc = __builtin_amdgcn_mfma_f32_16x16x32_bf16(vp[t][1], sf1, acc, 0, 0, 0);
                { const f32x4 hv4 = acc * inv; hpk[t].x = cvt_pk_bf16(hv4[0], hv4[1]); hpk[t].y = cvt_pk_bf16(hv4[2], hv4[3]); } }
            MS_HSTORE(0, hpk[0], hpk[1]);
            MS_SB();
            bf16x8 vq[2][2];
#pragma unroll
            for (int t = 0; t < 2; ++t)
#pragma unroll
                for (int ks = 0; ks < 2; ++ks) vq[t][ks] = trfrag_perm(Vi, 2 + t, ks, lane);
            MS_SB();
#pragma unroll
            for (int t = 0; t < 2; ++t) { f32x4 acc = acc3[2 + t];
                acc = __builtin_amdgcn_mfma_f32_16x16x32_bf16(vq[t][0], sf0, acc, 0, 0, 0);
                acc = __builtin_amdgcn_mfma_f32_16x16x32_bf16(vq[t][1], sf1, acc, 0, 0, 0);
                { const f32x4 hv4 = acc * inv; hpk[t].x = cvt_pk_bf16(hv4[0], hv4[1]); hpk[t].y = cvt_pk_bf16(hv4[2], hv4[3]); } }
            MS_HSTORE(1, hpk[0], hpk[1]);
#undef MS_HSTORE
        } else {
            const float gs = __expf(mt - M63);
            bf16x8 vf[4][2], ak[2][2];
#pragma unroll
            for (int c = 0; c < 4; ++c)
#pragma unroll
                for (int ks = 0; ks < 2; ++ks) vf[c][ks] = trfrag(Vi, c, ks, lane);
#pragma unroll
            for (int t = 0; t < 2; ++t)
#pragma unroll
                for (int ks = 0; ks < 2; ++ks) ak[t][ks] = trfrag(Kw, 2 * (w - 4) + t, ks, lane);
            MS_SB();
#pragma unroll
            for (int t = 0; t < 2; ++t) { const int dkt = 2 * (w - 4) + t;
#pragma unroll
                for (int c = 0; c < 4; ++c) { f32x4 acc = Cacc[t][c] * gs;
                    acc = __builtin_amdgcn_mfma_f32_16x16x32_bf16(ak[t][0], vf[c][0], acc, 0, 0, 0);
                    acc = __builtin_amdgcn_mfma_f32_16x16x32_bf16(ak[t][1], vf[c][1], acc, 0, 0, 0);
                    Cacc[t][c] = acc;
                    u32x2 pk; pk.x = cvt_pk_bf16(acc[0], acc[1]); pk.y = cvt_pk_bf16(acc[2], acc[3]);
                    const int dk0 = 16 * dkt + 4 * lg; *(LAS u32x2*)(Cbw + offb(16 * c + lr, dk0 >> 3) + 2 * (dk0 & 7)) = pk; }
                f32x4 na = nacc[t] * gs; na = __builtin_amdgcn_mfma_f32_16x16x32_bf16(ak[t][0], ones, na, 0, 0, 0); na = __builtin_amdgcn_mfma_f32_16x16x32_bf16(ak[t][1], ones, na, 0, 0, 0); nacc[t] = na;
                if (lr == 0) { u32x2 pn; pn.x = cvt_pk_bf16(na[0], na[1]); pn.y = cvt_pk_bf16(na[2], na[3]); *(LAS u32x2*)(nbw + (16 * dkt + 4 * lg) * 2) = pn; } }
        }
    };
#define MS_LOOP() for (int j = 0; j < nch; j += 2) {   \
        if (j + 2 < nch) MS_LOAD(j + 2, B); \
        chunk(j); \
        MS_STAGE(j + 1, 1, A); \
        __syncthreads(); \
        if (j + 3 < nch) MS_LOAD(j + 3, A); \
        chunk(j + 1); \
        if (j + 2 < nch) MS_STAGE(j + 2, 0, B); \
        __syncthreads(); }
    if (w < 4) { MS_LOOP() } else { MS_LOOP() }
#undef MS_LOOP
#undef MS_POS
#undef MS_LOAD
#undef MS_TOFF
#undef MS_STAGE
#undef MS_SB
}
}

__global__ void __launch_bounds__(NTHR, 2) fwd(Args args) {
    extern __shared__ __attribute__((aligned(16))) unsigned char lds[];
    LAS unsigned char* L = (LAS unsigned char*)lds;
    typedef const __attribute__((address_space(4))) Args* KArgs;
    const KArgs apk = (KArgs)__builtin_amdgcn_kernarg_segment_ptr();
    const int lo = apk->ph_lo, hi = apk->ph_hi;
    volatile LAS unsigned* MISC = (volatile LAS unsigned*)(L + LDS_MISC);
    if (threadIdx.x < 64) MISC[threadIdx.x] = 0u;
    __syncthreads();
    XcdBarrier bar = xcd_barrier_post((unsigned*)(apk->ws + WS_CTL), MISC + 8);
#ifdef DBG_ONLY
#define RUN(p, tag) ((tag) == DBG_ONLY && lo <= (p) && (p) < hi)
#else
#define RUN(p, tag) (lo <= (p) && (p) < hi)
#endif
#define SEAM(p) do { if ((p) + 1 < hi) xcd_barrier(bar); } while (0)
#define REP(bit) for (int rep_ = 0; rep_ < (((PROBE_MASK >> (bit)) & 1) ? 2 : 1); ++rep_)
#define PH_ENTER() KArgs ap = apk; asm volatile("" : "+s"(ap)); unsigned char* const ws = ap->ws; (void)ws; const int tid = opaque_tid(), lane = tid & 63; (void)lane; \
    const int wave = __builtin_amdgcn_readfirstlane(tid >> 6); (void)wave; int G = gridDim.x; asm volatile("" : "+s"(G)); const int bx = blockIdx.x; \
    const int vcu = (G % 8 == 0) ? (bx % 8) * (G / 8) + bx / 8 : bx; (void)vcu;     \
    const int gw = vcu * NWAVES + wave, NGW = G * NWAVES; (void)gw; (void)NGW
#define IN(k) (ap->in[k])
#define Zf ((float*)ap->out)
#define ZB ((bf16_t*)(ws + WS_ZB))
#define RSv ((f32x2*)(ws + WS_RS))
#define Pv ((f32x2*)(ws + WS_P))
#define RSID ((const f32x2*)(ws + WS_RSID))
#define ZERO ((const float*)(ws + WS_ZERO))
#define ONE ((const float*)(ws + WS_ONE))
#define C1 ((const float*)(ws + WS_C1))
#define C2 ((const float*)(ws + WS_C2))
#define GATES ((float*)(ws + WS_GATES))
#define LNG(i) (IN(IN_LNG) + (i) * DM)
#define LNB(i) (IN(IN_LNB) + (i) * DM)

    if (RUN(0, 100)) {
        PH_ENTER();
        const size_t gtid = (size_t)vcu * NTHR + tid, gthreads = (size_t)G * NTHR;
        LAS float* scr = (LAS float*)(L + wave * 8704);
        int base = 0;
        for (int j = 0; j < N_TJOBS; ++j) {
            TJob J; make_tjob(j, ap, J);
            const int nitems = J.nat ? (J.K / 64) * (J.N / 128) : (J.K / 64) * (J.N / 32);
            int start = (gw - base) % NGW; if (start < 0) start += NGW;
            if (J.nat) { for (int it = start; it < nitems; it += NGW) convert_item(J, it, lane); }
            else { for (int it = start; it < nitems; it += NGW) transpose_item(J, scr, it, lane); }
            base = (base + nitems) % NGW;
        }
        cvt_rows(IN(IN_MEMP), (bf16_t*)(ws + S_MEMB), (size_t)2048 * DM / 8, gtid, gthreads);
        cvt_rows(IN(IN_MEMS), (bf16_t*)(ws + S_MEMB) + (size_t)2048 * DM, (size_t)1024 * DM / 8, gtid, gthreads);
        cvt_rows_tiled(IN(IN_XP), ZB, (size_t)NPR * DM / 8, gtid, gthreads);
        cvt_rows_tiled(IN(IN_XS), ZB + (size_t)NPR * DM, (size_t)NPR * DM / 8, gtid, gthreads);
        for (size_t i = gtid; i < 8192; i += gthreads) ((float*)(ws + WS_ZERO))[i] = 0.f;
        for (size_t i = gtid; i < 2048; i += gthreads) ((float*)(ws + WS_ONE))[i] = 1.f;
        if (gtid == 0) *(f32x2*)(ws + WS_RSID) = (f32x2){0.f, 1.f};
        if (bx == 0 && tid < 32) {
            double f = 1.0; for (int i = 0; i < tid; ++i) f *= 0.7498942093324558;
            double x2 = f * f, cs = 1.0, sn = f, tc = 1.0, ts = f;
            for (int k = 1; k <= 12; ++k) { tc *= -x2 / (double)((2 * k - 1) * (2 * k)); ts *= -x2 / (double)((2 * k) * (2 * k + 1)); cs += tc; sn += ts; }
            double c = 1.0, s = 0.0; f32x2* tab = (f32x2*)(ws + WS_ROPE);
            for (int p = 0; p < 64; ++p) { tab[p * 32 + tid] = (f32x2){(float)c, (float)s}; const double c2 = c * cs - s * sn, s2 = s * cs + c * sn; c = c2; s = s2; }
        }
        SEAM(0);
    }
    if (RUN(1, 101)) {
        { PH_ENTER();
          const size_t gtid = (size_t)vcu * NTHR + tid, gthreads = (size_t)G * NTHR;
          const f32x2* cp = (const f32x2*)(ws + S_CPART);
          for (int q = 0; q < 11; ++q) {
              int cv, N;
              if (q == 0) { cv = CV_ATT_IN; N = ATT_IN; } else if (q < 3) { cv = CV_ML_IN + (q - 1) * ML_IN; N = ML_IN; } else if (q < 7) { cv = CV_XAQ + (q - 3) * DM; N = DM; } else { cv = CV_W1 + (q - 7) * DFF; N = DFF; }
              const f32x2* src = cp + (size_t)cv * 32;
              for (size_t n = gtid; n < (size_t)N; n += gthreads) { float a = 0.f, b = 0.f;
                  for (int kb = 0; kb < 32; ++kb) { const f32x2 v = src[(size_t)kb * N + n]; a += v.x; b += v.y; }
                  ((float*)(ws + WS_C1))[cv + n] = a; ((float*)(ws + WS_C2))[cv + n] = b; } } }
        { PH_ENTER();
          pg8::Gemm g{DM, DM, DM}; pg8::PlainOrder S; S.init(MEMROWS, 4 * DM, G, bx, ws + S_MEMB, DM, ws + S_WKT, DM);
          pg8::EpiIn E{(bf16_t*)(ws + WS_KMEM), 4 * DM, RSID, 0, ZERO, ZERO, 0};
          pg8::gemm_phase<pg8::EpiIn, pg8::PlainOrder, PG_ALIGN, PG_SP2>(L, g, S, E); }
        { PH_ENTER();
          pg8::Gemm g{DM, DM, DM}; pg8::PlainOrder S; S.init(MEMROWS, 4 * DM, G, G - 1 - bx, ws + S_MEMB, DM, ws + S_WVT, DM);
          pg8::EpiIn E{(bf16_t*)(ws + WS_VT), 4 * DM, RSID, 0, ZERO, ZERO, 0};
          pg8::gemm_phase<pg8::EpiIn, pg8::PlainOrder, PG_ALIGN, PG_SP2>(L, g, S, E); }
        SEAM(1);
    }

    for (int Ly = 0; Ly < 4; ++Ly) {
        const int pb = PH_LAYER0 + Ly * SLOTS;
        if ((Ly & 1) == 0) {
            if (RUN(pb + 0, 0)) {
            REP(0) {
                PH_ENTER(); const int jj = Ly >> 1; const bool first = (Ly == 0);
                pg8::Gemm g{DM, DM, DM}; pg8::PlainOrder S; S.init(NTOK, ATT_IN, G, bx, ZB, DM, ws + W_ATT_IN + (size_t)jj * 12 * MiB, DM);
                pg8::EpiQKV E{(bf16_t*)(ws + S_QKV), first ? RSID : RSv, first ? 0 : 1, first ? ZERO : C1 + CV_ATT_IN, first ? ZERO : C2 + CV_ATT_IN,
                              IN(IN_QGAIN) + jj * 128, IN(IN_KGAIN) + jj * 128, (const f32x2*)(ws + WS_ROPE), (LAS float*)(L + LDS_XL)};
                pg8::gemm_phase<pg8::EpiQKV, pg8::PlainOrder, true, PG_SP2, true>(L, g, S, E);
            }
                SEAM(pb + 0);
            }
            if (RUN(pb + 2, 2)) {
            REP(1) {
                PH_ENTER(); bf16_t* qkv = (bf16_t*)(ws + S_QKV); bf16_t* ob = (bf16_t*)(ws + S_OB);
                const int per = 1024 / G > 0 ? 1024 / G : 1;
                for (int half = 0; half < 2; ++half)
                    for (int u = vcu * per; u < 1024 && u < (vcu + 1) * per; ++u) {
                        int b, kvh, gq, qb, row0, brow, seq;
                        if (half == 0) { qb = u & 7; gq = (u >> 3) & 3; kvh = (u >> 5) & 3; b = u >> 7; brow = b * 2048; row0 = brow + qb * 256; seq = 2048; }
                        else { qb = u & 15; gq = (u >> 4) & 3; kvh = (u >> 6) & 3; b = u >> 8; brow = NPR + b * 4096; row0 = brow + qb * 256; seq = 4096; }
                        const int head = kvh * 4 + gq;
                        att::attn_dense_body(qkv + (size_t)row0 * ATT_IN + head * 128, qkv + (size_t)brow * ATT_IN + 2048 + kvh * 128, qkv + (size_t)brow * ATT_IN + 2560 + kvh * 128,
                                             ob, row0, head * 128, seq, (char*)lds);
                    }
            }
                SEAM(pb + 2);
            }
        } else {
            for (int grp = 0; grp < 2; ++grp) {
                if (RUN(pb + 3 * grp + 0, 20)) {
            REP(0) {
                    { PH_ENTER(); const int jj = Ly >> 1, r0 = grp * NPR, cvo = CV_ML_IN + jj * ML_IN;
                      pg8::Gemm g{DM, DM, DM}; pg8::PlainOrder S; S.init(NPR, ML_MAIN, G, bx, ZB + (size_t)r0 * DM, DM, ws + W_ML_IN + (size_t)jj * 25 * MiB, DM);
                      pg8::EpiInT E{(bf16_t*)(ws + S_H), ML_MAIN, RSv + r0, 1, C1 + cvo, C2 + cvo, 0};
                      pg8::gemm_phase<pg8::EpiInT, pg8::PlainOrder, PG_ALIGN, PG_SP2, true>(L, g, S, E); }
                    { PH_ENTER(); const int jj = Ly >> 1, r0 = grp * NPR, cvo = CV_ML_IN + jj * ML_IN;
                      const bf16_t* WgT = (const bf16_t*)(ws + W_ML_IN + (size_t)jj * 25 * MiB) + (size_t)ML_MAIN * DM;
                      const float* bg = IN(IN_ML_BGATE) + jj * 32; const bf16_t* zb = ZB; float* gates = GATES;
                      for (int it = gw; it < (grp == 0 ? NTOK / 16 : 0); it += NGW) {
                          const int rr = it * 16;
                          const bf16_t* Ap = zb + tile_off(rr + (lane & 15), 8 * (lane >> 4), DM);
                          const bf16_t* B0 = WgT + (size_t)(lane & 15) * DM + 8 * (lane >> 4); const bf16_t* B1 = B0 + (size_t)16 * DM;
                          f32x4 a0 = {0.f, 0.f, 0.f, 0.f}, a1 = {0.f, 0.f, 0.f, 0.f};
#pragma unroll 16
                          for (int kk = 0; kk < 64; ++kk) { const bf16x8 av = *(const bf16x8*)(Ap + kk * 512), b0 = *(const bf16x8*)(B0 + kk * 32), b1 = *(const bf16x8*)(B1 + kk * 32);
                              a0 = __builtin_amdgcn_mfma_f32_16x16x32_bf16(b0, av, a0, 0, 0, 0); a1 = __builtin_amdgcn_mfma_f32_16x16x32_bf16(b1, av, a1, 0, 0, 0); }
                          const int row = rr + (lane & 15); const f32x2 st = RSv[row];
#pragma unroll
                          for (int r = 0; r < 4; ++r) { const int n0 = 4 * (lane >> 4) + r, n1 = n0 + 16;
                              const float c10 = C1[cvo + ML_MAIN + n0], c20 = C2[cvo + ML_MAIN + n0] + bg[n0], c11 = C1[cvo + ML_MAIN + n1], c21 = C2[cvo + ML_MAIN + n1] + bg[n1];
                              gates[(size_t)n0 * NTOK + row] = (a0[r] - st.x * c10) * st.y + c20; gates[(size_t)n1 * NTOK + row] = (a1[r] - st.x * c11) * st.y + c21; }
                      } }
            }
                    SEAM(pb + 3 * grp + 0);
                }
                if (RUN(pb + 3 * grp + 1, 21)) {
            REP(2) {
                    PH_ENTER(); const int r0 = grp * NPR; const bf16_t* hbuf = (const bf16_t*)(ws + S_H); bf16_t* hf = (bf16_t*)(ws + S_HF); bf16_t* hbk = (bf16_t*)(ws + S_HB); const float* gates = GATES;
                    const int nb = grp == 0 ? 8 : 4, S_len = grp == 0 ? 2048 : 4096; const int nitems = nb * 8 * 2 * 4;
                    for (int it = vcu; it < nitems; it += G) {
                        const int sl = it & 3, dir = (it >> 2) & 1, hd = (it >> 3) & 7, b = it >> 6;
                        const size_t lrow = (size_t)b * S_len;
                        ms3::scan_item(hbuf + tile_off((int)lrow, hd * 128, ML_MAIN), hbuf + tile_off((int)lrow, 1024 + hd * 128, ML_MAIN), hbuf + tile_off((int)lrow, 2048 + hd * 256 + sl * 64, ML_MAIN),
                                  gates + (size_t)((dir * 2) * 8 + hd) * NTOK + r0 + lrow, gates + (size_t)((dir * 2 + 1) * 8 + hd) * NTOK + r0 + lrow,
                                  (dir ? hbk : hf) + lrow * DM + hd * 256 + sl * 64, S_len, dir, L);
                    }
            }
                    SEAM(pb + 3 * grp + 1);
                }
                if (RUN(pb + 3 * grp + 2, 22)) {
            REP(3) {
                    PH_ENTER(); const int jj = Ly >> 1, r0 = grp * NPR; const bf16_t* hbuf = (const bf16_t*)(ws + S_H); const bf16_t* hf = (const bf16_t*)(ws + S_HF); const bf16_t* hbk = (const bf16_t*)(ws + S_HB);
                    bf16_t* hsb = (bf16_t*)(ws + S_HSB);
                    const float* hg = IN(IN_ML_HGAIN) + jj * 2048;
                    for (int it0 = gw * 2; it0 < (NPR / 2) * 8; it0 += NGW * 2) {
                        u32x4 fa[2], fb[2], ow[2];
#pragma unroll
                        for (int q = 0; q < 2; ++q) { const int it = it0 + q, lrow = 2 * (it >> 3) + (lane >> 5), hd = it & 7, col = hd * 256 + (lane & 31) * 8;
                            fa[q] = *(const u32x4*)(hf + (size_t)lrow * DM + col); fb[q] = *(const u32x4*)(hbk + (size_t)lrow * DM + col);
                            ow[q] = *(const u32x4*)(hbuf + tile_off(lrow, 4096 + col, ML_MAIN)); }
#pragma unroll
                        for (int q = 0; q < 2; ++q) { const int it = it0 + q, lrow = 2 * (it >> 3) + (lane >> 5), hd = it & 7, col = hd * 256 + (lane & 31) * 8;
                            const u32x4 a = fa[q], b = fb[q], og = ow[q];
                            const f32x4 s0 = {bf2f(a.x & 0xffffu) + bf2f(b.x & 0xffffu), bf2f(a.x >> 16) + bf2f(b.x >> 16), bf2f(a.y & 0xffffu) + bf2f(b.y & 0xffffu), bf2f(a.y >> 16) + bf2f(b.y >> 16)};
                            const f32x4 s1 = {bf2f(a.z & 0xffffu) + bf2f(b.z & 0xffffu), bf2f(a.z >> 16) + bf2f(b.z >> 16), bf2f(a.w & 0xffffu) + bf2f(b.w & 0xffffu), bf2f(a.w >> 16) + bf2f(b.w >> 16)};
                            const f32x4 q0 = s0 * s0 + s1 * s1; float ssq = (q0[0] + q0[1]) + (q0[2] + q0[3]);
                            ssq += DPPF(0.f, ssq, 0xB1, 0xf); ssq += DPPF(0.f, ssq, 0x4E, 0xf); ssq += DPPF(0.f, ssq, 0x141, 0xf); ssq += DPPF(0.f, ssq, 0x140, 0xf); ssq = sum_x16(ssq);
                            const float rn = 1.0f / sqrtf(ssq * (1.f / 256.f) + RMS_EPS);
                            const f32x4 g0 = *(const f32x4*)(hg + col), g1 = *(const f32x4*)(hg + col + 4);
                            const f32x4 o0 = {bf2f(og.x & 0xffffu), bf2f(og.x >> 16), bf2f(og.y & 0xffffu), bf2f(og.y >> 16)}, o1 = {bf2f(og.z & 0xffffu), bf2f(og.z >> 16), bf2f(og.w & 0xffffu), bf2f(og.w >> 16)};
                            f32x4 y0, y1;
#pragma unroll
                            for (int e = 0; e < 4; ++e) { y0[e] = s0[e] * rn * g0[e] * __builtin_amdgcn_rcpf(1.f + __expf(-o0[e])); y1[e] = s1[e] * rn * g1[e] * __builtin_amdgcn_rcpf(1.f + __expf(-o1[e])); }
                            u32x4 w; w.x = cvt_pk_bf16(y0[0], y0[1]); w.y = cvt_pk_bf16(y0[2], y0[3]); w.z = cvt_pk_bf16(y1[0], y1[1]); w.w = cvt_pk_bf16(y1[2], y1[3]);
                            *(u32x4*)(hsb + tile_off(r0 + lrow, col, DM)) = w; }
                    }
            }
                    SEAM(pb + 3 * grp + 2);
                }
            }
        }
        if (RUN(pb + 6, 6)) {
            PH_ENTER(); const int jj = Ly >> 1; const bool first = (Ly == 0), isatt = (Ly & 1) == 0;
            const void* mix_out = isatt ? (const void*)(ws + S_OB) : (const void*)(ws + S_HSB);
            const void* w_out = isatt ? (const void*)(ws + W_ATT_OUT + (size_t)jj * 8 * MiB) : (const void*)(ws + W_ML_OUT + (size_t)jj * 8 * MiB);
            pg8::Gemm g{DM, DM, DM}; pg8::PlainOrder S; S.init(NTOK, DM, G, bx, mix_out, DM, w_out, DM);
            const int li = first ? 0 : (Ly - 1) * 3 + 2;
            pg8::EpiRes E{ZB, first ? RSID : RSv, first ? 0 : 1, first ? ONE : LNG(li), first ? ZERO : LNB(li), Pv};
            pg8::gemm_phase<pg8::EpiRes, pg8::PlainOrder, PG_ALIGN, PG_SP2, true>(L, g, S, E);
            SEAM(pb + 6);
        }
#define STATS_PHASE(ph) if (RUN(ph, 7)) { PH_ENTER(); const f32x2* P_ = Pv; f32x2* RS_ = RSv; \
            for (int it = gw; it < NTOK / 16; it += NGW) { const int row = it * 16 + (lane & 15), g_ = lane >> 4;     \
                float s = 0.f, q = 0.f; \
                _Pragma("unroll") for (int l_ = 0; l_ < 8; ++l_) { const f32x2 v = P_[(size_t)(g_ * 8 + l_) * NTOK + row]; s += v.x; q += v.y; } \
                s = sum_x32(sum_x16(s)); q = sum_x32(sum_x16(q)); \
                const float mean = s * (1.f / DM); const float var = q * (1.f / DM) - mean * mean; \
                if (lane < 16) RS_[row] = (f32x2){mean, 1.0f / sqrtf(var + LN_EPS)}; } \
            SEAM(ph); }
        if (RUN(pb + 7, 8)) {
            REP(0) {
            { PH_ENTER();
              struct MkOrder { int G, c, Ly; const char* km; const char* wq;
                  __device__ __forceinline__ bool next(int i, pg8::Unit& u) const { const int Lx = i * G + c; if (Lx >= 384) return false; u.pm = Lx >> 3; u.pn = Lx & 7;
                      u.a = km + ((size_t)(u.pm >> 2) * 256 * 8192 + Ly * 2048 + (u.pm & 3) * 512) * 2; u.b = wq + ((size_t)u.pn * 256 * DM + (u.pm & 3) * 512) * 2; return true; } };
              MkOrder S{G, vcu, Ly, (const char*)(ws + WS_KMEM), (const char*)(ws + W_XA_Q + (size_t)Ly * 8 * MiB)};
              int Km = 512; asm volatile("" : "+s"(Km)); pg8::Gemm g{4 * DM, DM, Km}; pg8::EpiIn E{(bf16_t*)(ws + S_QX), DM, RSID, 0, ZERO, ZERO, 0};
              pg8::gemm_phase<pg8::EpiIn, MkOrder, PG_ALIGN, PG_SP2>(L, g, S, E); }
            { PH_ENTER();
            struct VwOrder { int G, c, Ly; const char* wo; const char* vn;
                __device__ __forceinline__ bool next(int i, pg8::Unit& u) const { const int Lx = i * G + c; if (Lx >= 384) return false; u.pm = Lx >> 2; u.pn = Lx & 3;
                    u.a = wo + ((size_t)(u.pm & 7) * 256 * DM + u.pn * 512) * 2; u.b = vn + ((size_t)(u.pm >> 3) * 256 * 8192 + Ly * 2048 + u.pn * 512) * 2; return true; } };
            VwOrder S2{G, G - 1 - vcu, Ly, (const char*)(ws + W_XA_OUT + (size_t)Ly * 8 * MiB), (const char*)(ws + WS_VT)};
            int Kv = 512; asm volatile("" : "+s"(Kv)); pg8::Gemm g2{DM, 4 * DM, Kv}; pg8::EpiIn E2{(bf16_t*)(ws + S_OX), 1024, RSID, 0, ZERO, ZERO, 0};
            pg8::gemm_phase<pg8::EpiIn, VwOrder, PG_ALIGN, PG_SP2>(L, g2, S2, E2);
            }
            { PH_ENTER();
              const bf16_t* km = (const bf16_t*)(ws + WS_KMEM); const float* c1q = C1 + CV_XAQ + Ly * DM; const float* c2q = C2 + CV_XAQ + Ly * DM;
              float* c1s = (float*)(ws + WS_C1S); float* c2s = (float*)(ws + WS_C2S);
              for (int it = gw; it < 48 * 256; it += NGW) { const int mbh = it >> 8, m = it & 255, mb = mbh >> 2, h = mbh & 3;
                  const u32x4 kw = *(const u32x4*)(km + (size_t)(mb * 256 + m) * 8192 + Ly * 2048 + h * 512 + lane * 8);
                  const f32x4 a0 = *(const f32x4*)(c1q + h * 512 + lane * 8), a1 = *(const f32x4*)(c1q + h * 512 + lane * 8 + 4), b0 = *(const f32x4*)(c2q + h * 512 + lane * 8), b1 = *(const f32x4*)(c2q + h * 512 + lane * 8 + 4);
                  const f32x4 k0 = {bf2f(kw.x & 0xffffu), bf2f(kw.x >> 16), bf2f(kw.y & 0xffffu), bf2f(kw.y >> 16)}, k1 = {bf2f(kw.z & 0xffffu), bf2f(kw.z >> 16), bf2f(kw.w & 0xffffu), bf2f(kw.w >> 16)};
                  const f32x4 p1 = k0 * a0 + k1 * a1, p2 = k0 * b0 + k1 * b1;
                  const float s1 = wave_sum((p1[0] + p1[1]) + (p1[2] + p1[3])), s2 = wave_sum((p2[0] + p2[1]) + (p2[2] + p2[3]));
                  if (lane == 0) { c1s[it] = s1; c2s[it] = s2; } } }
            }
        }
        STATS_PHASE(pb + 7)
        if (RUN(pb + 9, 9)) {
            REP(0) {
            PH_ENTER();
            struct ScoreOrder { int G, c; const char* zb; const char* mk;
                __device__ __forceinline__ bool next(int i, pg8::Unit& u) const { const int Lx = i * G + c; if (Lx >= 512) return false; u.pm = Lx >> 2; u.pn = Lx & 3;
                    const int mb = u.pm < 64 ? (u.pm >> 3) : 8 + ((u.pm - 64) >> 4);
                    u.a = zb + (size_t)u.pm * 256 * DM * 2; u.b = mk + (size_t)(mb * 4 + u.pn) * 256 * DM * 2; return true; } };
            ScoreOrder S{G, vcu, (const char*)ZB, (const char*)(ws + S_QX)};
            pg8::Gemm g{DM, DM, DM}; pg8::EpiSoftmax E{(bf16_t*)(ws + S_PB), 1024, 0.04419417382415922f, (LAS float*)(L + LDS_XL), RSv, (const float*)(ws + WS_C1S), (const float*)(ws + WS_C2S)};
            pg8::gemm_phase<pg8::EpiSoftmax, ScoreOrder, true, PG_SP2, true>(L, g, S, E);
            }
            SEAM(pb + 9);
        }
        if (RUN(pb + 12, 12)) {
            PH_ENTER();
            struct XoOrder { int G, c; const char* pb_; const char* vw;
                __device__ __forceinline__ bool next(int i, pg8::Unit& u) const { const int Lx = i * G + c; if (Lx >= 1024) return false; u.pm = Lx >> 3; u.pn = Lx & 7;
                    const int mb = u.pm < 64 ? (u.pm >> 3) : 8 + ((u.pm - 64) >> 4);
                    u.a = pb_ + (size_t)u.pm * 256 * 1024 * 2; u.b = vw + ((size_t)(mb * 2048 + u.pn * 256) * 1024) * 2; return true; } };
            XoOrder S{G, vcu, (const char*)(ws + S_PB), (const char*)(ws + S_OX)};
            int Kx = 1024; asm volatile("" : "+s"(Kx)); pg8::Gemm g{1024, 1024, Kx};
            pg8::EpiRes E{ZB, RSv, 1, LNG(Ly * 3 + 0), LNB(Ly * 3 + 0), Pv};
            pg8::gemm_phase<pg8::EpiRes, XoOrder, PG_ALIGN, PG_SP2, true>(L, g, S, E);
            SEAM(pb + 12);
        }
        STATS_PHASE(pb + 13)
        for (int mg = 0; mg < MLP_NB; ++mg) {
        if (RUN(pb + 14 + 2 * mg, 14)) {
            REP(0) {
            PH_ENTER(); const int r0 = mg * (NTOK / MLP_NB);
            pg8::Gemm g{DM, DM, DM}; pg8::PlainOrder S; S.init(NTOK / MLP_NB, DFF, G, bx, ZB + (size_t)r0 * DM, DM, ws + W_W1 + (size_t)Ly * 32 * MiB, DM);
            pg8::EpiInT E{(bf16_t*)(ws + S_HID), DFF, RSv + r0, 1, C1 + CV_W1 + Ly * DFF, C2 + CV_W1 + Ly * DFF, 1};
            pg8::gemm_phase<pg8::EpiInT, pg8::PlainOrder, PG_ALIGN, PG_SP2, true>(L, g, S, E);
            }
            SEAM(pb + 14 + 2 * mg);
        }
        if (RUN(pb + 15 + 2 * mg, 15)) {
            PH_ENTER(); const int r0 = mg * (NTOK / MLP_NB);
            pg8::Gemm g{DFF, DFF, DFF}; pg8::PlainOrder S; S.init(NTOK / MLP_NB, DM, G, bx, ws + S_HID, DFF, ws + W_W2 + (size_t)Ly * 32 * MiB, DFF); S.rev = 1;
            pg8::EpiRes E{ZB + (size_t)r0 * DM, RSv + r0, 1, LNG(Ly * 3 + 1), LNB(Ly * 3 + 1), Pv + r0};
            pg8::gemm_phase<pg8::EpiRes, pg8::PlainOrder, PG_ALIGN, PG_SP2, true>(L, g, S, E);
            SEAM(pb + 15 + 2 * mg);
        }
        }
        STATS_PHASE(pb + 14 + 2 * MLP_NB)
    }
    if (RUN(PH_FINAL, 102)) {
        PH_ENTER(); float* z = Zf; const bf16_t* zb = ZB; const f32x2* RS_ = RSv;
        const float* gq = LNG(3 * 3 + 2); const float* bq = LNB(3 * 3 + 2);
        u32x4 zn[4]; f32x2 stn = RS_[gw];
#pragma unroll
        for (int j = 0; j < 4; ++j) zn[j] = *(const u32x4*)(zb + tile_off(gw, j * 512 + lane * 8, DM));
        for (int row = gw; row < NTOK; row += NGW) { const f32x2 st = stn; float* zr = z + (size_t)row * DM; u32x4 zc[4];
#pragma unroll
            for (int j = 0; j < 4; ++j) zc[j] = zn[j];
            if (row + NGW < NTOK) { stn = RS_[row + NGW];
#pragma unroll
                for (int j = 0; j < 4; ++j) zn[j] = *(const u32x4*)(zb + tile_off(row + NGW, j * 512 + lane * 8, DM)); }
#pragma unroll
            for (int j = 0; j < 4; ++j) { const int c = j * 512 + lane * 8; const u32x4 zw = zc[j];
                const f32x4 v0 = {bf2f(zw.x & 0xffffu), bf2f(zw.x >> 16), bf2f(zw.y & 0xffffu), bf2f(zw.y >> 16)}, v1 = {bf2f(zw.z & 0xffffu), bf2f(zw.z >> 16), bf2f(zw.w & 0xffffu), bf2f(zw.w >> 16)};
                const f32x4 g0 = *(const f32x4*)(gq + c), g1 = *(const f32x4*)(gq + c + 4), b0 = *(const f32x4*)(bq + c), b1 = *(const f32x4*)(bq + c + 4);
                *(f32x4*)(zr + c) = (v0 - st.x) * st.y * g0 + b0; *(f32x4*)(zr + c + 4) = (v1 - st.x) * st.y * g1 + b1; } }
    }
#undef RUN
#undef SEAM
#undef STATS_PHASE
}

static bool phase_used(int ph) {
    if (ph < PH_LAYER0 || ph >= PH_FINAL) return true;
    const int Ly = (ph - PH_LAYER0) / SLOTS, s = (ph - PH_LAYER0) % SLOTS;
    if ((Ly & 1) == 0 && ((s >= 3 && s <= 5) || s == 1)) return false;
    if (s == 8 || s == 10 || s == 11) return false;
    return true;
}
extern "C" void kernel_launch(void* const* d_in, const int* in_sizes, int n_in, void* d_out, int out_size, void* d_ws, size_t ws_size, hipStream_t stream) {
    static int grid = 0;
    if (grid == 0) {
        if (n_in != 19 || out_size != NTOK * DM || ws_size < WS_END) { fprintf(stderr, "kernel_launch: unexpected shapes: n_in %d out %d ws %zu (need %zu)\n", n_in, out_size, ws_size, (size_t)WS_END); grid = -1; return; }
        int dev = 0, cus = 0;
        if (hipGetDevice(&dev) != hipSuccess || hipDeviceGetAttribute(&cus, hipDeviceAttributeMultiprocessorCount, dev) != hipSuccess) { grid = -1; return; }
        if (hipFuncSetAttribute((const void*)fwd, hipFuncAttributeMaxDynamicSharedMemorySize, LDS_BYTES) != hipSuccess) { fprintf(stderr, "kernel_launch: hipFuncSetAttribute failed\n"); grid = -1; return; }
        int per_cu = 0;
        if (hipOccupancyMaxActiveBlocksPerMultiprocessor(&per_cu, (const void*)fwd, NTHR, LDS_BYTES) != hipSuccess || per_cu < 1) fprintf(stderr, "kernel_launch: occupancy query reports %d\n", per_cu);
        (void)hipGetLastError();
        grid = cus;
        if (grid != 256) fprintf(stderr, "kernel_launch: %d CUs (tuned for 256)\n", grid);
    }
    if (grid < 0) return;
    (void)hipMemsetAsync((char*)d_ws + WS_CTL, 0, CTL_ZERO_BYTES, stream);
    Args a{};
    for (int i = 0; i < 19; ++i) a.in[i] = (const float*)d_in[i];
    a.out = (float*)d_out; a.ws = (unsigned char*)d_ws;
#if MK_ONE_LAUNCH
    a.ph_lo = 0; a.ph_hi = PH_END;
    hipLaunchKernelGGL(fwd, dim3(grid), dim3(NTHR), LDS_BYTES, stream, a);
#else
    for (int ph = 0; ph < PH_END; ++ph) { if (!phase_used(ph)) continue; a.ph_lo = ph; a.ph_hi = ph + 1; hipLaunchKernelGGL(fwd, dim3(grid), dim3(NTHR), LDS_BYTES, stream, a); }
#endif
    const hipError_t le = hipPeekAtLastError();
    if (le != hipSuccess) fprintf(stderr, "kernel_launch: launch failed: %s\n", hipGetErrorName(le));
}
```

```cpp
#include <hip/hip_runtime.h>
#include <cstdio>
#include <cstdint>

#ifndef PROBE_MASK
#define PROBE_MASK 0
#endif
#ifndef PG_ALIGN
#define PG_ALIGN true
#endif
#ifndef PG_SP2
#define PG_SP2 true
#endif
#ifndef MK_ONE_LAUNCH
#define MK_ONE_LAUNCH 1
#endif

#define LAS __attribute__((address_space(3)))
typedef unsigned short bf16_t;
typedef short bf16x8 __attribute__((ext_vector_type(8)));
typedef short s16x4 __attribute__((ext_vector_type(4)));
typedef float f32x2 __attribute__((ext_vector_type(2)));
typedef float f32x4 __attribute__((ext_vector_type(4)));
typedef float f32x16 __attribute__((ext_vector_type(16)));
typedef unsigned u32x2 __attribute__((ext_vector_type(2)));
typedef unsigned u32x4 __attribute__((ext_vector_type(4)));

constexpr int DM = 2048, NTOK = 32768, NPR = 16384;
constexpr int MEMROWS = 3072;
constexpr int ATT_IN = 3072, ML_MAIN = 6144, ML_IN = 6176, DFF = 8192;
constexpr float DN_ALPHA = 1.681792830507429f, LN_EPS = 1e-5f, RMS_EPS = 1e-6f;
constexpr int NWAVES = 8, NTHR = 512;

constexpr size_t MiB = 1u << 20;
constexpr size_t WS_CTL = 0, CTL_ZERO_BYTES = 64 * 1024;
constexpr size_t WS_ROPE = 1 * MiB;
constexpr size_t WS_ZERO = WS_ROPE + 64 * 1024;
constexpr size_t WS_ONE = WS_ZERO + 32 * 1024;
constexpr size_t WS_RSID = WS_ONE + 8 * 1024;
constexpr size_t WS_C1 = WS_ROPE + 256 * 1024;
constexpr size_t WS_C2 = WS_C1 + 256 * 1024;
constexpr size_t WS_C1S = WS_C2 + 256 * 1024, WS_C2S = WS_C1S + 64 * 1024;
constexpr size_t WS_RS = 2 * MiB;
constexpr size_t WS_GATES = 3 * MiB;
constexpr size_t WS_P = 8 * MiB;
constexpr size_t WS_W = 16 * MiB;
constexpr size_t W_ATT_IN = WS_W;
constexpr size_t W_ATT_OUT = W_ATT_IN + 24 * MiB;
constexpr size_t W_ML_IN = W_ATT_OUT + 16 * MiB;
constexpr size_t W_ML_OUT = W_ML_IN + 50 * MiB;
constexpr size_t W_XA_Q = W_ML_OUT + 16 * MiB;
constexpr size_t W_XA_OUT = W_XA_Q + 32 * MiB;
constexpr size_t W_W1 = W_XA_OUT + 32 * MiB;
constexpr size_t W_W2 = W_W1 + 128 * MiB;
constexpr size_t WS_KMEM = W_W2 + 128 * MiB;
constexpr size_t WS_VT = WS_KMEM + 48 * MiB;
constexpr size_t WS_ZB = WS_VT + 48 * MiB;
constexpr size_t WS_S = WS_ZB + 128 * MiB;
constexpr size_t S_WKT = WS_S, S_WVT = WS_S + 32 * MiB, S_MEMB = WS_S + 64 * MiB, S_CPART = WS_S + 80 * MiB;
constexpr size_t S_QKV = WS_S, S_OB = WS_S + 192 * MiB;
constexpr size_t S_H = WS_S, S_HF = WS_S + 192 * MiB, S_HB = WS_S + 320 * MiB, S_HSB = WS_S + 448 * MiB;
constexpr size_t S_QX = WS_S, S_SC = WS_S + 128 * MiB, S_PB = WS_S + 256 * MiB, S_OX = WS_S + 320 * MiB;
constexpr size_t S_HID = WS_S;
constexpr size_t WS_END = WS_S + 576 * MiB;
constexpr int CV_ATT_IN = 0, CV_ML_IN = 3072, CV_XAQ = 3072 + 2 * 6176, CV_W1 = CV_XAQ + 4 * 2048, CV_END = CV_W1 + 4 * 8192;

constexpr int LDS_BYTES = 155648, LDS_MISC = 131072, LDS_XL = 131072 + 4096, LDS_PAR = 147456;

__device__ __forceinline__ unsigned f2bf(float f) { unsigned u = __float_as_uint(f); return (u + 0x7fffu + ((u >> 16) & 1u)) >> 16; }
__device__ __forceinline__ float bf2f(unsigned b) { return __uint_as_float(b << 16); }
__device__ __forceinline__ unsigned pk2(float lo, float hi) { return f2bf(lo) | (f2bf(hi) << 16); }
typedef __bf16 bf16x2_t __attribute__((ext_vector_type(2)));
__device__ __forceinline__ unsigned cvt_pk_bf16(float lo, float hi) { f32x2 v = {lo, hi}; bf16x2_t b = __builtin_convertvector(v, bf16x2_t); return __builtin_bit_cast(unsigned, b); }
__device__ __forceinline__ float sum_x16(float v) { auto r = __builtin_amdgcn_permlane16_swap(__float_as_uint(v), __float_as_uint(v), false, false); return __uint_as_float(r[0]) + __uint_as_float(r[1]); }
__device__ __forceinline__ float sum_x32(float v) { auto r = __builtin_amdgcn_permlane32_swap(__float_as_uint(v), __float_as_uint(v), false, false); return __uint_as_float(r[0]) + __uint_as_float(r[1]); }
__device__ __forceinline__ float max_x16(float v) { auto r = __builtin_amdgcn_permlane16_swap(__float_as_uint(v), __float_as_uint(v), false, false); return fmaxf(__uint_as_float(r[0]), __uint_as_float(r[1])); }
__device__ __forceinline__ float max_x32(float v) { auto r = __builtin_amdgcn_permlane32_swap(__float_as_uint(v), __float_as_uint(v), false, false); return fmaxf(__uint_as_float(r[0]), __uint_as_float(r[1])); }
#define DPPF(old, v, ctrl, rmask) __int_as_float(__builtin_amdgcn_update_dpp(__float_as_int(old), __float_as_int(v), (ctrl), (rmask), 0xf, false))
__device__ __forceinline__ float sum8(float v) { v += DPPF(0.f, v, 0xB1, 0xf); v += DPPF(0.f, v, 0x4E, 0xf); v += DPPF(0.f, v, 0x141, 0xf); return v; }
__device__ __forceinline__ float scan_add(float v) { v += DPPF(0.f, v, 0x111, 0xf); v += DPPF(0.f, v, 0x112, 0xf); v += DPPF(0.f, v, 0x114, 0xf); v += DPPF(0.f, v, 0x118, 0xf);
    v += DPPF(0.f, v, 0x142, 0xa); v += DPPF(0.f, v, 0x143, 0xc); return v; }
__device__ __forceinline__ float scan_max(float v) { const float ninf = -3.0e38f; v = fmaxf(v, DPPF(ninf, v, 0x111, 0xf)); v = fmaxf(v, DPPF(ninf, v, 0x112, 0xf)); v = fmaxf(v, DPPF(ninf, v, 0x114, 0xf)); v = fmaxf(v, DPPF(ninf, v, 0x118, 0xf));
    v = fmaxf(v, DPPF(ninf, v, 0x142, 0xa)); v = fmaxf(v, DPPF(ninf, v, 0x143, 0xc)); return v; }
__device__ __forceinline__ float wave_sum(float v) { v += DPPF(0.f, v, 0xB1, 0xf); v += DPPF(0.f, v, 0x4E, 0xf); v += DPPF(0.f, v, 0x141, 0xf); v += DPPF(0.f, v, 0x140, 0xf); return sum_x32(sum_x16(v)); }
__device__ __forceinline__ float wave_max(float v) { v = fmaxf(v, DPPF(v, v, 0xB1, 0xf)); v = fmaxf(v, DPPF(v, v, 0x4E, 0xf)); v = fmaxf(v, DPPF(v, v, 0x141, 0xf)); v = fmaxf(v, DPPF(v, v, 0x140, 0xf)); return max_x32(max_x16(v)); }
#define LDS_WAIT() asm volatile("s_waitcnt lgkmcnt(0)" ::: "memory")
__device__ __forceinline__ int opaque_tid() { int t = threadIdx.x; asm volatile("" : "+v"(t)); return t; }

__host__ __device__ __forceinline__ size_t tile_off(int r, int c, int ld) { return ((size_t)(r >> 4) * (ld >> 5) + (c >> 5)) * 512 + (r & 15) * 32 + (c & 31); }
namespace pg8 {
constexpr int BM = 256, BK = 64, HALF = 128, HTB = HALF * BK * 2, STAGE_BYTES = 8 * HTB, NXCD = 8, WGM = 4;
__host__ __device__ __forceinline__ int lds_byte(int r, int c) { const int st = (r >> 4) * 2 + (c >> 5), rr = r & 15, cc = c & 31, ob = rr * 64 + cc * 2; return st * 1024 + (ob ^ (((ob >> 9) & 1) << 5)); }
__host__ __device__ __forceinline__ void stage_rc(int b, int& R, int& C) { const int st = b / 1024, sb = b % 1024, swz = sb ^ (((sb >> 9) & 1) << 5); R = (st >> 1) * 16 + swz / 64; C = (st & 1) * 32 + (swz % 64) / 2; }
__host__ __device__ __forceinline__ int perm32(int rho) { const int n = rho >> 4, i = rho & 15; return 8 * (i >> 2) + 4 * n + (i & 3); }

struct Unit { int pm, pn; const char* a; const char* b; };
struct Gemm { int lda, ldb, K; };

struct PlainOrder {
    int nM, nN, nwg, G, c; const char* A; const char* B; size_t tA, tB; int rev = 0;
    __device__ __forceinline__ void init(int M, int N, int G_, int c_, const void* A_, int lda, const void* B_, int ldb) {
        nM = M / BM; nN = N / BM; nwg = nM * nN; G = G_; c = c_; A = (const char*)A_; B = (const char*)B_; tA = (size_t)BM * lda * 2; tB = (size_t)BM * ldb * 2; }
    __device__ __forceinline__ bool next(int i, Unit& u) const {
        long L = (long)i * G + c; if (L >= nwg) return false;
        if (rev) { const int nr = (nwg + G - 1) / G; L = (long)(nr - 1 - i) * G + c; if (L >= nwg) return false; }
        int wgid = (int)L; { const int q = nwg / NXCD, r = nwg % NXCD, xcd = wgid % NXCD, off = wgid / NXCD; wgid = (xcd < r ? xcd * (q + 1) : r * (q + 1) + (xcd - r) * q) + off; }
        const int nig = WGM * nN, gid = wgid / nig, fm = gid * WGM, gsz = (nM - fm) < WGM ? (nM - fm) : WGM;
        u.pm = fm + ((wgid % nig) % gsz); u.pn = (wgid % nig) / gsz; u.a = A + (size_t)u.pm * tA; u.b = B + (size_t)u.pn * tB; return true;
    }
};

template <class Epi, class Sched, bool ALIGN_EPI, bool SP2, bool ATILE = false>
__device__ __forceinline__ void gemm_phase(LAS unsigned char* lds, const Gemm g, const Sched& S, const Epi& E) {
    const int tid = opaque_tid(), wid = __builtin_amdgcn_readfirstlane(tid >> 6), lane = tid & 63, wr = wid >> 2, wc = wid & 3, fr = lane & 15, fq = lane >> 4;
    const int K = g.K, nt = K / BK;
    unsigned voffA[2], voffB[2];
#pragma unroll
    for (int i = 0; i < 2; ++i) { int R, C; stage_rc(tid * 16 + i * 8192, R, C); const int Rb = Epi::PERM ? ((R & ~31) + perm32(R & 31)) : R;
        voffA[i] = ATILE ? (unsigned)(((R >> 4) * (g.lda >> 5) + (C >> 5)) * 512 + (R & 15) * 32 + (C & 31)) * 2u : (unsigned)(R * g.lda + C) * 2u; voffB[i] = (unsigned)(Rb * g.ldb + C) * 2u; }
    const size_t kstep = (size_t)(BK * 2), kstepA = ATILE ? (size_t)2048 : kstep;
    const size_t hA = (size_t)HALF * g.lda * 2, hB = (size_t)HALF * g.ldb * 2;
    const unsigned ldsw = (unsigned)wid * 1024u;
    const int aoff = lds_byte(wr * 64 + fr, fq * 8), boff = lds_byte(wc * 32 + fr, fq * 8);
#define PG8_SA(b, h) (((b) * 2 + (h)) * HTB)
#define PG8_SB(b, h) ((4 + (b) * 2 + (h)) * HTB)
#define PG8_STAGE(bufoff, gbase, voff) do { _Pragma("unroll") for (int _i = 0; _i < 2; ++_i) \
        __builtin_amdgcn_global_load_lds((const unsigned*)((const char*)(gbase) + (voff)[_i]), (LAS unsigned*)(lds + (bufoff) + ldsw + _i * 8192), 16, 0, 0); } while (0)
#define PG8_LDA(dst, b, h) do { _Pragma("unroll") for (int m = 0; m < 4; ++m) _Pragma("unroll") for (int k = 0; k < 2; ++k) dst[m][k] = *(const LAS bf16x8*)(lds + PG8_SA(b, h) + aoff + m * 2048 + k * 1024); } while (0)
#define PG8_LDB(dst, b, h) do { _Pragma("unroll") for (int n = 0; n < 2; ++n) _Pragma("unroll") for (int k = 0; k < 2; ++k) dst[n][k] = *(const LAS bf16x8*)(lds + PG8_SB(b, h) + boff + n * 2048 + k * 1024); } while (0)
#define PG8_MMA(ai, bj, At, Bt) do { __builtin_amdgcn_s_setprio(1); _Pragma("unroll") for (int m = 0; m < 4; ++m) _Pragma("unroll") for (int n = 0; n < 2; ++n) _Pragma("unroll") for (int k = 0; k < 2; ++k) \
        acc[ai][bj][m][n] = __builtin_amdgcn_mfma_f32_16x16x32_bf16(Bt[n][k], At[m][k], acc[ai][bj][m][n], 0, 0, 0); __builtin_amdgcn_s_setprio(0); } while (0)
#define PG8_WAIT_V(n) asm volatile("s_waitcnt vmcnt(" #n ")" ::: "memory")
#define PG8_WAIT_L(n) asm volatile("s_waitcnt lgkmcnt(" #n ")" ::: "memory")
#define PG8_BAR __builtin_amdgcn_s_barrier()
#define PG8_SCHED __builtin_amdgcn_sched_barrier(0)
    Unit cur, nxt; int ui = 0;
    if (!S.next(0, cur)) return;
    if constexpr (Epi::PSTAGE) E.stage(cur, lds + LDS_PAR, tid);
    f32x4 acc[2][2][4][2];
#pragma unroll
    for (int a = 0; a < 2; ++a)
#pragma unroll
        for (int b = 0; b < 2; ++b)
#pragma unroll
            for (int m = 0; m < 4; ++m)
#pragma unroll
                for (int n = 0; n < 2; ++n) acc[a][b][m][n] = (f32x4){0.f, 0.f, 0.f, 0.f};
    bf16x8 At[4][2], B0[2][2], B1[2][2];
    const char* cA = cur.a; const char* cB = cur.b;
    if constexpr (SP2) {
        PG8_STAGE(PG8_SB(0, 0), cB, voffB); PG8_STAGE(PG8_SB(0, 1), cB + hB, voffB); PG8_STAGE(PG8_SA(0, 0), cA, voffA); PG8_STAGE(PG8_SA(0, 1), cA + hA, voffA);
        if (wr == 1) PG8_BAR;
        PG8_WAIT_V(2); PG8_BAR;
        PG8_STAGE(PG8_SB(1, 0), cB + kstep, voffB); PG8_STAGE(PG8_SA(1, 0), cA + kstepA, voffA); PG8_STAGE(PG8_SB(1, 1), cB + hB + kstep, voffB);
        PG8_WAIT_V(6); PG8_BAR;
    } else {
        PG8_STAGE(PG8_SB(0, 0), cB, voffB); PG8_STAGE(PG8_SA(0, 0), cA, voffA); PG8_STAGE(PG8_SB(0, 1), cB + hB, voffB); PG8_STAGE(PG8_SA(0, 1), cA + hA, voffA);
        if (wr == 1) PG8_BAR;
        PG8_WAIT_V(4); PG8_BAR;
        PG8_STAGE(PG8_SB(1, 0), cB + kstep, voffB); PG8_STAGE(PG8_SA(1, 0), cA + kstepA, voffA); PG8_STAGE(PG8_SB(1, 1), cB + hB + kstep, voffB);
        PG8_WAIT_V(6); PG8_BAR;
    }
    for (;;) {
        const bool has_next = S.next(ui + 1, nxt);
        const char* nA = has_next ? nxt.a : cA; const char* nB = has_next ? nxt.b : cB;
        for (int t = 0; t < nt; t += 2) {
            const bool last = (t == nt - 2);
            const char* a1 = cA + (size_t)(t + 1) * kstepA;
            const char* a2 = last ? nA : cA + (size_t)(t + 2) * kstepA; const char* b2 = last ? nB : cB + (size_t)(t + 2) * kstep;
            const char* a3 = a2 + kstepA; const char* b3 = b2 + kstep;
            if constexpr (SP2) {
            PG8_LDB(B0, 0, 0); PG8_LDB(B1, 0, 1); PG8_SCHED; PG8_LDA(At, 0, 0); PG8_STAGE(PG8_SA(1, 1), a1 + hA, voffA);
            PG8_WAIT_V(8); PG8_WAIT_L(0); PG8_BAR; PG8_MMA(0, 0, At, B0); PG8_MMA(0, 1, At, B1); PG8_BAR; PG8_SCHED;
            PG8_LDA(At, 0, 1); PG8_STAGE(PG8_SB(0, 0), b2, voffB); PG8_STAGE(PG8_SB(0, 1), b2 + hB, voffB); PG8_STAGE(PG8_SA(0, 0), a2, voffA);
            PG8_WAIT_V(8); PG8_WAIT_L(0); PG8_BAR; PG8_MMA(1, 0, At, B0); PG8_MMA(1, 1, At, B1); PG8_BAR; PG8_SCHED;
            PG8_LDB(B0, 1, 0); PG8_LDB(B1, 1, 1); PG8_SCHED; PG8_LDA(At, 1, 0); PG8_STAGE(PG8_SA(0, 1), a2 + hA, voffA);
            PG8_WAIT_V(8); PG8_WAIT_L(0); PG8_BAR; PG8_MMA(0, 0, At, B0); PG8_MMA(0, 1, At, B1); PG8_BAR; PG8_SCHED;
            PG8_LDA(At, 1, 1); PG8_STAGE(PG8_SB(1, 0), b3, voffB); PG8_STAGE(PG8_SB(1, 1), b3 + hB, voffB); PG8_STAGE(PG8_SA(1, 0), a3, voffA);
            PG8_WAIT_V(8); PG8_WAIT_L(0); PG8_BAR; PG8_MMA(1, 0, At, B0); PG8_MMA(1, 1, At, B1); PG8_BAR; PG8_SCHED;
            } else {
            PG8_LDB(B0, 0, 0); PG8_SCHED; PG8_LDA(At, 0, 0); PG8_STAGE(PG8_SA(1, 1), a1 + hA, voffA);
            PG8_WAIT_L(8); PG8_BAR; PG8_WAIT_L(0); PG8_MMA(0, 0, At, B0); PG8_BAR; PG8_SCHED;
            PG8_LDB(B1, 0, 1); PG8_STAGE(PG8_SB(0, 0), b2, voffB);
            PG8_BAR; PG8_WAIT_L(0); PG8_MMA(0, 1, At, B1); PG8_BAR;
            PG8_LDA(At, 0, 1); PG8_STAGE(PG8_SA(0, 0), a2, voffA);
            PG8_BAR; PG8_WAIT_L(0); PG8_MMA(1, 0, At, B0); PG8_BAR; PG8_SCHED;
            PG8_STAGE(PG8_SB(0, 1), b2 + hB, voffB);
            PG8_WAIT_V(6); PG8_BAR; PG8_MMA(1, 1, At, B1); PG8_BAR;
            PG8_LDB(B0, 1, 0); PG8_SCHED; PG8_LDA(At, 1, 0); PG8_STAGE(PG8_SA(0, 1), a2 + hA, voffA);
            PG8_WAIT_L(8); PG8_BAR; PG8_WAIT_L(0); PG8_MMA(0, 0, At, B0); PG8_BAR; PG8_SCHED;
            PG8_LDB(B1, 1, 1); PG8_STAGE(PG8_SB(1, 0), b3, voffB);
            PG8_BAR; PG8_WAIT_L(0); PG8_MMA(0, 1, At, B1); PG8_BAR;
            PG8_LDA(At, 1, 1); PG8_STAGE(PG8_SA(1, 0), a3, voffA);
            PG8_BAR; PG8_WAIT_L(0); PG8_MMA(1, 0, At, B0); PG8_BAR; PG8_SCHED;
            PG8_STAGE(PG8_SB(1, 1), b3 + hB, voffB);
            PG8_WAIT_V(6); PG8_BAR; PG8_MMA(1, 1, At, B1); PG8_BAR;
            }
        }
        if constexpr (ALIGN_EPI) { if (wr == 0) PG8_BAR; }
        E(acc, cur, wr, wc, fr, fq, (LAS const float*)(lds + LDS_PAR + (ui & 1) * 4096));
        if (!has_next) break;
#pragma unroll
        for (int a = 0; a < 2; ++a)
#pragma unroll
            for (int b = 0; b < 2; ++b)
#pragma unroll
                for (int m = 0; m < 4; ++m)
#pragma unroll
                    for (int n = 0; n < 2; ++n) acc[a][b][m][n] = (f32x4){0.f, 0.f, 0.f, 0.f};
        cur = nxt; cA = nA; cB = nB; ++ui;
        if constexpr (Epi::PSTAGE) E.stage(cur, lds + LDS_PAR + (ui & 1) * 4096, tid);
        if constexpr (ALIGN_EPI) { if (wr == 1) PG8_BAR; }
    }
    PG8_WAIT_V(0);
    if constexpr (!ALIGN_EPI) { if (wr == 0) PG8_BAR; }
    PG8_BAR;
#undef PG8_SA
#undef PG8_SB
#undef PG8_STAGE
#undef PG8_LDA
#undef PG8_LDB
#undef PG8_MMA
#undef PG8_WAIT_V
#undef PG8_WAIT_L
#undef PG8_BAR
#undef PG8_SCHED
}

struct EpiIn {
    static constexpr bool PERM = true, PSTAGE = true;
    __device__ __forceinline__ void stage(const Unit& u, LAS unsigned char* buf, int tid) const {
        const unsigned wv = (unsigned)__builtin_amdgcn_readfirstlane(tid >> 6);
        const float* g0 = (const float*)rs + (size_t)(u.pm * BM + (tid >> 1)) * rs_mul * 2 + (tid & 1);
        __builtin_amdgcn_global_load_lds((const unsigned*)g0, (LAS unsigned*)(buf + wv * 256u), 4, 0, 0);
        const float* g1 = (tid < 256 ? c1 : c2 - 256) + u.pn * BM + tid;
        __builtin_amdgcn_global_load_lds((const unsigned*)g1, (LAS unsigned*)(buf + 2048u + wv * 256u), 4, 0, 0);
    }
    bf16_t* out; int ldc; const f32x2* rs; int rs_mul; const float* c1; const float* c2; int act;
    __device__ __forceinline__ void operator()(f32x4 (&acc)[2][2][4][2], const Unit& u, int wr, int wc, int fr, int fq, LAS const float* pp) const {
        const int row0 = u.pm * BM + wr * 64 + fr, col0 = u.pn * BM + wc * 32 + 8 * fq;
        f32x4 c1v[2][2], c2v[2][2];
#pragma unroll
        for (int bj = 0; bj < 2; ++bj)
#pragma unroll
            for (int n = 0; n < 2; ++n) { c1v[bj][n] = *(const LAS f32x4*)(pp + 512 + wc * 32 + 8 * fq + bj * HALF + 4 * n); c2v[bj][n] = *(const LAS f32x4*)(pp + 768 + wc * 32 + 8 * fq + bj * HALF + 4 * n); }
        f32x2 stv[2][4];
#pragma unroll
        for (int ai = 0; ai < 2; ++ai)
#pragma unroll
            for (int m = 0; m < 4; ++m) stv[ai][m] = *(const LAS f32x2*)(pp + 2 * (wr * 64 + fr + ai * HALF + m * 16));
#pragma unroll
        for (int ai = 0; ai < 2; ++ai)
#pragma unroll
            for (int m = 0; m < 4; ++m) { const int r = row0 + ai * HALF + m * 16; const f32x2 st = stv[ai][m]; bf16_t* rowp = out + (size_t)r * ldc + col0;
#pragma unroll
                for (int bj = 0; bj < 2; ++bj) {
                    f32x4 v0 = (acc[ai][bj][m][0] - st.x * c1v[bj][0]) * st.y + c2v[bj][0], v1 = (acc[ai][bj][m][1] - st.x * c1v[bj][1]) * st.y + c2v[bj][1];
                    if (act == 1) {
#pragma unroll
                        for (int j = 0; j < 4; ++j) { const float a = fmaxf(v0[j], 0.f), b = fmaxf(v1[j], 0.f); v0[j] = a * a; v1[j] = b * b; } }
                    u32x4 w; w.x = cvt_pk_bf16(v0[0], v0[1]); w.y = cvt_pk_bf16(v0[2], v0[3]); w.z = cvt_pk_bf16(v1[0], v1[1]); w.w = cvt_pk_bf16(v1[2], v1[3]);
                    *(u32x4*)(rowp + bj * HALF) = w; } }
    }
};
struct EpiInT {
    static constexpr bool PERM = true, PSTAGE = true;
    __device__ __forceinline__ void stage(const Unit& u, LAS unsigned char* buf, int tid) const {
        const unsigned wv = (unsigned)__builtin_amdgcn_readfirstlane(tid >> 6);
        const float* g0 = (const float*)rs + (size_t)(u.pm * BM + (tid >> 1)) * rs_mul * 2 + (tid & 1);
        __builtin_amdgcn_global_load_lds((const unsigned*)g0, (LAS unsigned*)(buf + wv * 256u), 4, 0, 0);
        const float* g1 = (tid < 256 ? c1 : c2 - 256) + u.pn * BM + tid;
        __builtin_amdgcn_global_load_lds((const unsigned*)g1, (LAS unsigned*)(buf + 2048u + wv * 256u), 4, 0, 0);
    }
    bf16_t* out; int ldc; const f32x2* rs; int rs_mul; const float* c1; const float* c2; int act;
    __device__ __forceinline__ void operator()(f32x4 (&acc)[2][2][4][2], const Unit& u, int wr, int wc, int fr, int fq, LAS const float* pp) const {
        const int row0 = u.pm * BM + wr * 64 + fr, col0 = u.pn * BM + wc * 32 + 8 * fq;
        f32x4 c1v[2][2], c2v[2][2];
#pragma unroll
        for (int bj = 0; bj < 2; ++bj)
#pragma unroll
            for (int n = 0; n < 2; ++n) { c1v[bj][n] = *(const LAS f32x4*)(pp + 512 + wc * 32 + 8 * fq + bj * HALF + 4 * n); c2v[bj][n] = *(const LAS f32x4*)(pp + 768 + wc * 32 + 8 * fq + bj * HALF + 4 * n); }
        f32x2 stv[2][4];
#pragma unroll
        for (int ai = 0; ai < 2; ++ai)
#pragma unroll
            for (int m = 0; m < 4; ++m) stv[ai][m] = *(const LAS f32x2*)(pp + 2 * (wr * 64 + fr + ai * HALF + m * 16));
#pragma unroll
        for (int ai = 0; ai < 2; ++ai)
#pragma unroll
            for (int m = 0; m < 4; ++m) { const int r = row0 + ai * HALF + m * 16; const f32x2 st = stv[ai][m]; bf16_t* rowp = out + ((size_t)(r >> 4) * (ldc >> 5) + (col0 >> 5)) * 512 + (r & 15) * 32 + (col0 & 31);
#pragma unroll
                for (int bj = 0; bj < 2; ++bj) {
                    f32x4 v0 = (acc[ai][bj][m][0] - st.x * c1v[bj][0]) * st.y + c2v[bj][0], v1 = (acc[ai][bj][m][1] - st.x * c1v[bj][1]) * st.y + c2v[bj][1];
                    if (act == 1) {
#pragma unroll
                        for (int j = 0; j < 4; ++j) { const float a = fmaxf(v0[j], 0.f), b = fmaxf(v1[j], 0.f); v0[j] = a * a; v1[j] = b * b; } }
                    u32x4 w; w.x = cvt_pk_bf16(v0[0], v0[1]); w.y = cvt_pk_bf16(v0[2], v0[3]); w.z = cvt_pk_bf16(v1[0], v1[1]); w.w = cvt_pk_bf16(v1[2], v1[3]);
                    *(u32x4*)(rowp + bj * (HALF / 32) * 512) = w; } }
    }
};
struct EpiSoftmax {
    static constexpr bool PERM = true, PSTAGE = true;
    __device__ __forceinline__ void stage(const Unit& u, LAS unsigned char* buf, int tid) const {
        const unsigned wv = (unsigned)__builtin_amdgcn_readfirstlane(tid >> 6);
        const int mb = u.pm < 64 ? (u.pm >> 3) : 8 + ((u.pm - 64) >> 4);
        const float* g0 = (const float*)rs + (size_t)(u.pm * BM + (tid >> 1)) * 2 + (tid & 1);
        __builtin_amdgcn_global_load_lds((const unsigned*)g0, (LAS unsigned*)(buf + wv * 256u), 4, 0, 0);
        const float* g1 = (tid < 256 ? c1 : c2 - 256) + (mb * 4 + u.pn) * BM + tid;
        __builtin_amdgcn_global_load_lds((const unsigned*)g1, (LAS unsigned*)(buf + 2048u + wv * 256u), 4, 0, 0);
    }
    bf16_t* out; int ldc; float scale; LAS float* xl;
    const f32x2* rs; const float* c1; const float* c2;
    __device__ __forceinline__ void operator()(f32x4 (&acc)[2][2][4][2], const Unit& u, int wr, int wc, int fr, int fq, LAS const float* pp) const {
        const int col0 = u.pn * BM + wc * 32 + 8 * fq; const float sl2 = scale * 1.4426950408889634f;
        const int mb = u.pm < 64 ? (u.pm >> 3) : 8 + ((u.pm - 64) >> 4); const int cc = (mb * 4 + u.pn) * BM + wc * 32 + 8 * fq;
        f32x4 c1v[4], c2v[4];
#pragma unroll
        for (int q = 0; q < 4; ++q) { const LAS float* pc = pp + 512 + wc * 32 + 8 * fq + (q >> 1) * HALF + 4 * (q & 1); c1v[q] = *(const LAS f32x4*)pc; c2v[q] = *(const LAS f32x4*)(pc + 256); }
#pragma unroll
        for (int ai = 0; ai < 2; ++ai)
#pragma unroll
            for (int m = 0; m < 4; ++m) { const int rl = ai * HALF + wr * 64 + m * 16 + fr; const f32x2 st = *(const LAS f32x2*)(pp + 2 * rl);
                f32x4 a0 = ((acc[ai][0][m][0] - st.x * c1v[0]) * st.y + c2v[0]) * sl2, a1 = ((acc[ai][0][m][1] - st.x * c1v[1]) * st.y + c2v[1]) * sl2;
                f32x4 a2 = ((acc[ai][1][m][0] - st.x * c1v[2]) * st.y + c2v[2]) * sl2, a3 = ((acc[ai][1][m][1] - st.x * c1v[3]) * st.y + c2v[3]) * sl2;
                float mx = fmaxf(fmaxf(fmaxf(a0[0], a0[1]), fmaxf(a0[2], a0[3])), fmaxf(fmaxf(a1[0], a1[1]), fmaxf(a1[2], a1[3])));
                mx = fmaxf(mx, fmaxf(fmaxf(fmaxf(a2[0], a2[1]), fmaxf(a2[2], a2[3])), fmaxf(fmaxf(a3[0], a3[1]), fmaxf(a3[2], a3[3]))));
                mx = max_x32(max_x16(mx));
                float sm = 0.f;
#pragma unroll
                for (int j = 0; j < 4; ++j) { a0[j] = __builtin_amdgcn_exp2f(a0[j] - mx); a1[j] = __builtin_amdgcn_exp2f(a1[j] - mx); a2[j] = __builtin_amdgcn_exp2f(a2[j] - mx); a3[j] = __builtin_amdgcn_exp2f(a3[j] - mx);
                    sm += (a0[j] + a1[j]) + (a2[j] + a3[j]); }
                sm = sum_x32(sum_x16(sm));
                acc[ai][0][m][0] = a0; acc[ai][0][m][1] = a1; acc[ai][1][m][0] = a2; acc[ai][1][m][1] = a3;
                if (fq == 0) *(LAS f32x2*)(xl + (rl * 4 + wc) * 2) = (f32x2){mx, sm}; }
        asm volatile("s_waitcnt lgkmcnt(0)" ::: "memory"); __builtin_amdgcn_s_barrier(); asm volatile("" ::: "memory");
#pragma unroll
        for (int ai = 0; ai < 2; ++ai)
#pragma unroll
            for (int m = 0; m < 4; ++m) { int rl = ai * HALF + wr * 64 + m * 16 + fr; asm volatile("" : "+v"(rl));
                const f32x4 t0 = *(const LAS f32x4*)(xl + rl * 8), t1 = *(const LAS f32x4*)(xl + rl * 8 + 4);
                const float M = fmaxf(fmaxf(t0[0], t0[2]), fmaxf(t1[0], t1[2]));
                const float Lsum = (t0[1] * __builtin_amdgcn_exp2f(t0[0] - M) + t0[3] * __builtin_amdgcn_exp2f(t0[2] - M)) + (t1[1] * __builtin_amdgcn_exp2f(t1[0] - M) + t1[3] * __builtin_amdgcn_exp2f(t1[2] - M));
                const float mine = (wc == 0) ? t0[0] : (wc == 1) ? t0[2] : (wc == 2) ? t1[0] : t1[2];
                const float f = __builtin_amdgcn_exp2f(mine - M) * __builtin_amdgcn_rcpf(Lsum);
                bf16_t* rowp = out + tile_off(u.pm * BM + rl, col0, ldc);
#pragma unroll
                for (int bj = 0; bj < 2; ++bj) { const f32x4 v0 = acc[ai][bj][m][0] * f, v1 = acc[ai][bj][m][1] * f;
                    u32x4 w; w.x = cvt_pk_bf16(v0[0], v0[1]); w.y = cvt_pk_bf16(v0[2], v0[3]); w.z = cvt_pk_bf16(v1[0], v1[1]); w.w = cvt_pk_bf16(v1[2], v1[3]);
                    *(u32x4*)(rowp + bj * (HALF / 32) * 512) = w; } }
    }
};
struct EpiRes {
    static constexpr bool PERM = true, PSTAGE = false;
    bf16_t* zb; const f32x2* rs; int rs_mul; const float* g; const float* b; f32x2* P;
    __device__ __forceinline__ void operator()(f32x4 (&acc)[2][2][4][2], const Unit& u, int wr, int wc, int fr, int fq, LAS const float* pp) const {
        const int row0 = u.pm * BM + wr * 64 + fr, col0 = u.pn * BM + wc * 32 + 8 * fq;
        f32x4 gv[2][2], bv[2][2];
#pragma unroll
        for (int bj = 0; bj < 2; ++bj)
#pragma unroll
            for (int n = 0; n < 2; ++n) { gv[bj][n] = *(const f32x4*)(g + col0 + bj * HALF + 4 * n); bv[bj][n] = *(const f32x4*)(b + col0 + bj * HALF + 4 * n); }
        u32x4 zw[4][2]; f32x2 stv[4];
#pragma unroll
        for (int m = 0; m < 4; ++m) { const int r = row0 + m * 16; stv[m] = rs[(size_t)r * rs_mul];
#pragma unroll
            for (int bj = 0; bj < 2; ++bj) zw[m][bj] = *(const u32x4*)(zb + tile_off(r, col0, DM) + bj * (HALF / 32) * 512); }
#pragma unroll
        for (int ai = 0; ai < 2; ++ai)
#pragma unroll
            for (int m = 0; m < 4; ++m) { const int r = row0 + ai * HALF + m * 16; const f32x2 st = stv[m]; bf16_t* zp = zb + tile_off(r, col0, DM);
                const float nm = -st.x * st.y;
                f32x4 sv = {0.f, 0.f, 0.f, 0.f}, qv = {0.f, 0.f, 0.f, 0.f};
#pragma unroll
                for (int bj = 0; bj < 2; ++bj) {
                    const u32x4 zq = zw[m][bj];
                    const f32x4 zo0 = {bf2f(zq.x & 0xffffu), bf2f(zq.x >> 16), bf2f(zq.y & 0xffffu), bf2f(zq.y >> 16)}, zo1 = {bf2f(zq.z & 0xffffu), bf2f(zq.z >> 16), bf2f(zq.w & 0xffffu), bf2f(zq.w >> 16)};
                    const f32x4 x0 = (zo0 * st.y + nm) * gv[bj][0] + bv[bj][0], x1 = (zo1 * st.y + nm) * gv[bj][1] + bv[bj][1];
                    const f32x4 n0 = x0 * DN_ALPHA + acc[ai][bj][m][0], n1 = x1 * DN_ALPHA + acc[ai][bj][m][1];
                    u32x4 w; w.x = cvt_pk_bf16(n0[0], n0[1]); w.y = cvt_pk_bf16(n0[2], n0[3]); w.z = cvt_pk_bf16(n1[0], n1[1]); w.w = cvt_pk_bf16(n1[2], n1[3]);
                    *(u32x4*)(zp + bj * (HALF / 32) * 512) = w;
                    sv += n0; sv += n1; qv = n0 * n0 + qv; qv = n1 * n1 + qv; }
                if (ai == 0) { const int r2 = r + HALF; stv[m] = rs[(size_t)r2 * rs_mul];
#pragma unroll
                    for (int bj = 0; bj < 2; ++bj) zw[m][bj] = *(const u32x4*)(zb + tile_off(r2, col0, DM) + bj * (HALF / 32) * 512); }
                float s = (sv[0] + sv[1]) + (sv[2] + sv[3]), ss = (qv[0] + qv[1]) + (qv[2] + qv[3]);
                s = sum_x32(sum_x16(s)); ss = sum_x32(sum_x16(ss));
                if (fq == 0) P[(size_t)(u.pn * 4 + wc) * NTOK + r] = (f32x2){s, ss}; }
    }
};
struct EpiQKV {
    static constexpr bool PERM = true, PSTAGE = true;
    __device__ __forceinline__ void stage(const Unit& u, LAS unsigned char* buf, int tid) const {
        const unsigned wv = (unsigned)__builtin_amdgcn_readfirstlane(tid >> 6);
        const float* g0 = (const float*)rs + (size_t)(u.pm * BM + (tid >> 1)) * rs_mul * 2 + (tid & 1);
        __builtin_amdgcn_global_load_lds((const unsigned*)g0, (LAS unsigned*)(buf + wv * 256u), 4, 0, 0);
        const float* g1 = (tid < 256 ? c1 : c2 - 256) + u.pn * BM + tid;
        __builtin_amdgcn_global_load_lds((const unsigned*)g1, (LAS unsigned*)(buf + 2048u + wv * 256u), 4, 0, 0);
    }
    bf16_t* out; const f32x2* rs; int rs_mul; const float* c1; const float* c2; const float* qg; const float* kg; const f32x2* tab; LAS float* xl;
    __device__ __forceinline__ void operator()(f32x4 (&acc)[2][2][4][2], const Unit& u, int wr, int wc, int fr, int fq, LAS const float* pp) const {
        const int row0 = u.pm * BM + wr * 64 + fr, col0 = u.pn * BM + wc * 32 + 8 * fq;
        const bool isv = u.pn >= 10;
        f32x4 c1q[2][2], c2q[2][2]; f32x2 stq[2][4];
#pragma unroll
        for (int bj = 0; bj < 2; ++bj) { const LAS float* pc = pp + 512 + wc * 32 + 8 * fq + bj * HALF; c1q[bj][0] = *(const LAS f32x4*)pc; c1q[bj][1] = *(const LAS f32x4*)(pc + 4); c2q[bj][0] = *(const LAS f32x4*)(pc + 256); c2q[bj][1] = *(const LAS f32x4*)(pc + 260); }
#pragma unroll
        for (int ai = 0; ai < 2; ++ai)
#pragma unroll
            for (int m = 0; m < 4; ++m) stq[ai][m] = *(const LAS f32x2*)(pp + 2 * (ai * HALF + wr * 64 + m * 16 + fr));
#pragma unroll
        for (int bj = 0; bj < 2; ++bj) {
            const f32x4 c10 = c1q[bj][0], c11 = c1q[bj][1], c20 = c2q[bj][0], c21 = c2q[bj][1];
#pragma unroll
            for (int ai = 0; ai < 2; ++ai)
#pragma unroll
                for (int m = 0; m < 4; ++m) { int rl = ai * HALF + wr * 64 + m * 16 + fr; asm volatile("" : "+v"(rl)); const f32x2 st = stq[ai][m];
                    const f32x4 v0 = (acc[ai][bj][m][0] - st.x * c10) * st.y + c20, v1 = (acc[ai][bj][m][1] - st.x * c11) * st.y + c21;
                    acc[ai][bj][m][0] = v0; acc[ai][bj][m][1] = v1;
                    if (!isv) { float ss = (v0[0] * v0[0] + v0[1] * v0[1]) + (v0[2] * v0[2] + v0[3] * v0[3]) + (v1[0] * v1[0] + v1[1] * v1[1]) + (v1[2] * v1[2] + v1[3] * v1[3]);
                        ss = sum_x32(sum_x16(ss));
                        if (fq == 0) xl[(rl * 2 + bj) * 4 + wc] = ss; } }
            asm volatile("" ::: "memory"); }
        if (isv) {
#pragma unroll
            for (int ai = 0; ai < 2; ++ai)
#pragma unroll
                for (int m = 0; m < 4; ++m) { int rr = row0 + ai * HALF + m * 16; asm volatile("" : "+v"(rr)); bf16_t* rowp = out + (size_t)rr * ATT_IN + col0;
#pragma unroll
                    for (int bj = 0; bj < 2; ++bj) { const f32x4 v0 = acc[ai][bj][m][0], v1 = acc[ai][bj][m][1];
                        u32x4 w; w.x = cvt_pk_bf16(v0[0], v0[1]); w.y = cvt_pk_bf16(v0[2], v0[3]); w.z = cvt_pk_bf16(v1[0], v1[1]); w.w = cvt_pk_bf16(v1[2], v1[3]);
                        *(u32x4*)(rowp + bj * HALF) = w; } }
        }
        asm volatile("s_waitcnt lgkmcnt(0)" ::: "memory"); __builtin_amdgcn_s_barrier(); asm volatile("" ::: "memory");
        if (!isv) {
            const int sec = wc >> 1, xi = (wc & 1) * 16 + fq * 4, e1 = sec * 64 + xi;
            const float* gn = (u.pn < 8) ? qg : kg;
            const f32x4 g1 = *(const f32x4*)(gn + e1), g2 = *(const f32x4*)(gn + e1 + 32);
            auto cs_row = [&](int q_) -> const f32x2* { int rl_ = (q_ >> 2) * HALF + wr * 64 + (q_ & 3) * 16 + fr; const int r_ = u.pm * BM + rl_;
                const int pos_ = r_ < NPR ? (r_ & 2047) : (r_ & 4095); const int pid_ = sec == 0 ? (pos_ >> 6) : (pos_ & 63); return tab + pid_ * 32 + xi; };
            f32x4 csn01 = *(const f32x4*)cs_row(0), csn23 = *(const f32x4*)(cs_row(0) + 2);
#pragma unroll
            for (int ai = 0; ai < 2; ++ai)
#pragma unroll
                for (int m = 0; m < 4; ++m) { int rl = ai * HALF + wr * 64 + m * 16 + fr; asm volatile("" : "+v"(rl));
                    const int r = u.pm * BM + rl;
                    const f32x4 cs01 = csn01, cs23 = csn23;
                    if (ai * 4 + m < 7) { const f32x2* nx_ = cs_row(ai * 4 + m + 1); csn01 = *(const f32x4*)nx_; csn23 = *(const f32x4*)(nx_ + 2); }
                    const f32x4 cv = {cs01[0], cs01[2], cs23[0], cs23[2]}, sv = {cs01[1], cs01[3], cs23[1], cs23[3]};
#pragma unroll
                    for (int bj = 0; bj < 2; ++bj) {
                        const f32x4 t = *(const LAS f32x4*)(xl + (rl * 2 + bj) * 4);
                        const float rn = __builtin_amdgcn_rsqf(((t[0] + t[1]) + (t[2] + t[3])) * (1.f / 128.f) + RMS_EPS);
                        const f32x4 x1 = acc[ai][bj][m][0] * rn * g1, x2 = acc[ai][bj][m][1] * rn * g2;
                        const f32x4 o1 = x1 * cv - x2 * sv, o2 = x1 * sv + x2 * cv;
                        bf16_t* hp = out + (size_t)r * ATT_IN + col0 + bj * HALF;
                        u32x4 w; w.x = cvt_pk_bf16(o1[0], o1[1]); w.y = cvt_pk_bf16(o1[2], o1[3]); w.z = cvt_pk_bf16(o2[0], o2[1]); w.w = cvt_pk_bf16(o2[2], o2[3]);
                        *(u32x4*)hp = w; }
                    asm volatile("" ::: "memory"); }
        }
    }
};
}

namespace att {
constexpr int D = 128, NW = 8, QBLK = 32, KVBLK = 64;
constexpr float SCALE = 0.088388347648318440f, THR = 8.f;
constexpr int LDQ = ATT_IN, LDK = ATT_IN, LDO = DM;
constexpr size_t SHM_V = KVBLK * D * 2, SHM_K = KVBLK * D * 2, SHM_ATTN = 2 * SHM_V + 2 * SHM_K + NW * 64 * 4;
#define KSWZ(row, colB) ((row) * 256 + ((colB) ^ (((row) & 7) << 4)))
#define SBAR() __builtin_amdgcn_sched_barrier(0)
__device__ __forceinline__ int crow(int r, int hi) { return (r & 3) + 8 * (r >> 2) + 4 * hi; }
__device__ __forceinline__ void partialSM(f32x16& p0, f32x16& p1, float& m_reg, float& mn, float& alpha) {
  constexpr float C = SCALE * 1.4426950408889634f;
  float pmax = p0[0]; for (int r = 1; r < 16; ++r) pmax = fmaxf(pmax, p0[r]); for (int r = 0; r < 16; ++r) pmax = fmaxf(pmax, p1[r]);
  { auto rr = __builtin_amdgcn_permlane32_swap(__float_as_uint(pmax), __float_as_uint(pmax), false, false);
    pmax = fmaxf(__uint_as_float(rr[0]), __uint_as_float(rr[1])); }
  if (__builtin_expect(__all(pmax - m_reg <= THR / SCALE), 1)) { mn = m_reg; alpha = 1.f; }
  else { mn = fmaxf(m_reg, pmax); alpha = __builtin_amdgcn_exp2f((m_reg - mn) * C); m_reg = mn; }
  float mnC = -mn * C;
  for (int r = 0; r < 16; ++r) p0[r] = fmaf(p0[r], C, mnC); for (int r = 0; r < 16; ++r) p1[r] = fmaf(p1[r], C, mnC);
  for (int r = 0; r < 16; ++r) p0[r] = __builtin_amdgcn_exp2f(p0[r]);
}
__device__ __forceinline__ void finishSM(f32x16& p0, f32x16& p1, float alpha, float& l_reg, bf16x8& pa0, bf16x8& pa1, bf16x8& pa2, bf16x8& pa3) {
  for (int r = 0; r < 16; ++r) p1[r] = __builtin_amdgcn_exp2f(p1[r]);
  float ps = 0; for (int r = 0; r < 16; ++r) ps += p0[r]; for (int r = 0; r < 16; ++r) ps += p1[r];
  { auto rr = __builtin_amdgcn_permlane32_swap(__float_as_uint(ps), __float_as_uint(ps), false, false);
    ps = __uint_as_float(rr[0]) + __uint_as_float(rr[1]); }
  l_reg = l_reg * alpha + ps;
#define PK4(P, BASE, OUT) do { unsigned a0 = cvt_pk_bf16(P[BASE + 0], P[BASE + 1]), a1 = cvt_pk_bf16(P[BASE + 2], P[BASE + 3]);   \
    unsigned b0 = cvt_pk_bf16(P[BASE + 4], P[BASE + 5]), b1 = cvt_pk_bf16(P[BASE + 6], P[BASE + 7]);                              \
    auto r0 = __builtin_amdgcn_permlane32_swap(a0, b0, false, false); auto r1 = __builtin_amdgcn_permlane32_swap(a1, b1, false, false); \
    u32x4 w = {r0[0], r1[0], r0[1], r1[1]}; OUT = *reinterpret_cast<bf16x8*>(&w); } while (0)
  PK4(p0, 0, pa0); PK4(p0, 8, pa1); PK4(p1, 0, pa2); PK4(p1, 8, pa3);
#undef PK4
}
__device__ __forceinline__ void qkt(f32x16& p0, f32x16& p1, const bf16_t* Ks, const bf16x8* qr, int r32, int hi) {
  p0 = f32x16{}; p1 = f32x16{};
  for (int d0 = 0; d0 < 8; ++d0) { int cb = (d0 * 16 + hi * 8) * 2;
    bf16x8 b0 = *reinterpret_cast<const bf16x8*>((const char*)Ks + KSWZ(r32, cb));
    bf16x8 b1 = *reinterpret_cast<const bf16x8*>((const char*)Ks + KSWZ(32 + r32, cb));
    p0 = __builtin_amdgcn_mfma_f32_32x32x16_bf16(b0, qr[d0], p0, 0, 0, 0);
    p1 = __builtin_amdgcn_mfma_f32_32x32x16_bf16(b1, qr[d0], p1, 0, 0, 0); }
}
__device__ __forceinline__ int v_st(int k, int c) { const int kk = (k & ~0xC) | ((k & 4) << 1) | ((k & 8) >> 1); return ((kk >> 3) * 4 + (c >> 5)) * 512 + ((kk & 7) * 32 + (c & 31)) * 2; }
__device__ __forceinline__ int v_rd_base(int lane) { return ((lane & 3) << 3) | (((lane >> 2) & 3) << 6) | (((lane >> 4) & 1) << 5) | (((lane >> 5) & 1) << 8); }
constexpr int v_rd_off(int d0, int ks, int half) { return d0 * 512 + ks * 4096 + half * 2048; }
template <int OFF> __device__ __forceinline__ s16x4 tr_read(int vb) {
  s16x4 r; asm volatile("ds_read_b64_tr_b16 %0, %1 offset:%2" : "=&v"(r) : "v"(vb), "i"(OFF) : "memory"); return r;
}
template <int D0> __device__ __forceinline__ void pv_one(f32x16& od, int vb, bf16x8 pa0, bf16x8 pa1, bf16x8 pa2, bf16x8 pa3) {
  const s16x4 l0 = tr_read<v_rd_off(D0, 0, 0)>(vb), h0 = tr_read<v_rd_off(D0, 0, 1)>(vb), l1 = tr_read<v_rd_off(D0, 1, 0)>(vb), h1 = tr_read<v_rd_off(D0, 1, 1)>(vb);
  const s16x4 l2 = tr_read<v_rd_off(D0, 2, 0)>(vb), h2 = tr_read<v_rd_off(D0, 2, 1)>(vb), l3 = tr_read<v_rd_off(D0, 3, 0)>(vb), h3 = tr_read<v_rd_off(D0, 3, 1)>(vb);
  asm volatile("s_waitcnt lgkmcnt(0)" ::: "memory"); SBAR();
#define PK(L, H) (bf16x8){L[0], L[1], L[2], L[3], H[0], H[1], H[2], H[3]}
  od = __builtin_amdgcn_mfma_f32_32x32x16_bf16(pa0, PK(l0, h0), od, 0, 0, 0);
  od = __builtin_amdgcn_mfma_f32_32x32x16_bf16(pa1, PK(l1, h1), od, 0, 0, 0);
  od = __builtin_amdgcn_mfma_f32_32x32x16_bf16(pa2, PK(l2, h2), od, 0, 0, 0);
  od = __builtin_amdgcn_mfma_f32_32x32x16_bf16(pa3, PK(l3, h3), od, 0, 0, 0);
#undef PK
}
__device__ __forceinline__ void pv_d0(f32x16* o, int vb, bf16x8 pa0, bf16x8 pa1, bf16x8 pa2, bf16x8 pa3) {
  pv_one<0>(o[0], vb, pa0, pa1, pa2, pa3); pv_one<1>(o[1], vb, pa0, pa1, pa2, pa3); pv_one<2>(o[2], vb, pa0, pa1, pa2, pa3); pv_one<3>(o[3], vb, pa0, pa1, pa2, pa3);
}
__device__ __forceinline__ void attn_dense_body(const bf16_t* __restrict__ Qb, const bf16_t* __restrict__ Kh, const bf16_t* __restrict__ Vh, bf16_t* __restrict__ Ob, int orow0, int ocol0, int seq, char* lds) {
  const int tid = opaque_tid(), wid = tid >> 6, lane = tid & 63, r32 = lane & 31, hi = lane >> 5;
  bf16_t* V_lds = (bf16_t*)lds; bf16_t* K_lds = (bf16_t*)(lds + 2 * SHM_V);
  float* ws = (float*)(lds + 2 * SHM_V + 2 * SHM_K) + wid * 64; float* li_l = ws; float* al_l = ws + 32;
  float m_reg = -1e30f, l_reg = 0; f32x16 o[4] = {}; bf16x8 qr[8];
  const bf16_t* Qw = Qb + (long)(wid * QBLK + r32) * LDQ + hi * 8;
#pragma unroll
  for (int d0 = 0; d0 < 8; ++d0) qr[d0] = *reinterpret_cast<const bf16x8*>(Qw + d0 * 16);
  const int sr = tid >> 4, sc = (tid & 15) * 8, vst0 = v_st(sr, sc), vst1 = v_st(32 + sr, sc);
  const int vb0 = (int)(uintptr_t)V_lds + v_rd_base(lane);
  struct { bf16x8 vs0, vs1, ks0, ks1; } sr_[2];
#define SLOAD(i, k0) do { sr_[i].vs0 = *reinterpret_cast<const bf16x8*>(&Vh[(long)((k0) + sr) * LDK + sc]); sr_[i].vs1 = *reinterpret_cast<const bf16x8*>(&Vh[(long)((k0) + 32 + sr) * LDK + sc]); \
    sr_[i].ks0 = *reinterpret_cast<const bf16x8*>(&Kh[(long)((k0) + sr) * LDK + sc]); sr_[i].ks1 = *reinterpret_cast<const bf16x8*>(&Kh[(long)((k0) + 32 + sr) * LDK + sc]); } while (0)
#define SWRITE(b, i) do { *(bf16x8*)((char*)V_lds + (b) * SHM_V + vst0) = sr_[i].vs0;          \
    *(bf16x8*)((char*)V_lds + (b) * SHM_V + vst1) = sr_[i].vs1; int kc = sc * 2;               \
    *(bf16x8*)((char*)K_lds + (b) * SHM_K + KSWZ(sr, kc)) = sr_[i].ks0;                       \
    *(bf16x8*)((char*)K_lds + (b) * SHM_K + KSWZ(32 + sr, kc)) = sr_[i].ks1; } while (0)
#define SWAIT() asm volatile("s_waitcnt vmcnt(4)" ::: "memory")
#define RESC(a) do { if (__any((a) < 1.f)) { if (hi == 0) al_l[r32] = (a); asm volatile("s_waitcnt lgkmcnt(0)" ::: "memory"); \
    for (int d = 0; d < 4; ++d) for (int r = 0; r < 16; ++r) o[d][r] *= al_l[crow(r, hi)]; } } while (0)
  f32x16 pA0, pA1, pB0, pB1; float mnA, mnB, alA, alB; bf16x8 pa0, pa1, pa2, pa3; const int NT = seq / KVBLK;
  constexpr int SE = 0, SO = 1;
  SLOAD(SE, 0); SLOAD(SO, KVBLK); asm volatile("s_waitcnt vmcnt(4)" ::: "memory"); SWRITE(0, SE); __syncthreads();
  if (2 < NT) SLOAD(SE, 2 * KVBLK);
  qkt(pA0, pA1, K_lds, qr, r32, hi); partialSM(pA0, pA1, m_reg, mnA, alA);
  SWAIT(); SWRITE(1, SO); __syncthreads();
  for (int j = 1; j + 1 < NT; j += 2) {
    SBAR(); qkt(pB0, pB1, (bf16_t*)((char*)K_lds + SHM_K), qr, r32, hi);
    finishSM(pA0, pA1, alA, l_reg, pa0, pa1, pa2, pa3); SBAR();
    SLOAD(SO, (j + 2) * KVBLK); SBAR();
    pv_d0(o, vb0, pa0, pa1, pa2, pa3); partialSM(pB0, pB1, m_reg, mnB, alB);
    __syncthreads(); SWAIT(); SWRITE(0, SE);
    RESC(alB); __syncthreads();
    SBAR(); qkt(pA0, pA1, K_lds, qr, r32, hi);
    finishSM(pB0, pB1, alB, l_reg, pa0, pa1, pa2, pa3); SBAR();
    if (j + 3 < NT) SLOAD(SE, (j + 3) * KVBLK); SBAR();
    pv_d0(o, vb0 + (int)SHM_V, pa0, pa1, pa2, pa3); partialSM(pA0, pA1, m_reg, mnA, alA);
    __syncthreads(); SWAIT(); SWRITE(1, SO);
    RESC(alA); __syncthreads();
  }
  SBAR(); qkt(pB0, pB1, (bf16_t*)((char*)K_lds + SHM_K), qr, r32, hi);
  finishSM(pA0, pA1, alA, l_reg, pa0, pa1, pa2, pa3); SBAR();
  pv_d0(o, vb0, pa0, pa1, pa2, pa3); partialSM(pB0, pB1, m_reg, mnB, alB);
  __syncthreads(); RESC(alB);
  finishSM(pB0, pB1, alB, l_reg, pa0, pa1, pa2, pa3); SBAR();
  pv_d0(o, vb0 + (int)SHM_V, pa0, pa1, pa2, pa3);
  if (hi == 0) li_l[r32] = l_reg; asm volatile("s_waitcnt lgkmcnt(0)" ::: "memory");
  float rli[16];
#pragma unroll
  for (int r = 0; r < 16; ++r) rli[r] = __builtin_amdgcn_rcpf(li_l[crow(r, hi)]);
  { const bool odd = (lane & 1) != 0; const int c2 = r32 & ~1;
    bf16_t* Ow = Ob + tile_off(orow0 + wid * QBLK + 4 * hi + (odd ? 1 : 0), ocol0 + c2, LDO);
#pragma unroll
    for (int p = 0; p < 8; ++p) { const int ra = 2 * p, rb = 2 * p + 1;
      const int rowoff = ((ra & 3) + 8 * (ra >> 2));
      const size_t eoff = (size_t)(rowoff >> 4) * (LDO >> 5) * 512 + (size_t)(rowoff & 15) * 32;
#pragma unroll
      for (int d0 = 0; d0 < 4; ++d0) { const float a = o[d0][ra] * rli[ra], b = o[d0][rb] * rli[rb];
        const float snd = odd ? a : b; const float rcv = __int_as_float(__builtin_amdgcn_mov_dpp(__float_as_int(snd), 0xB1, 0xf, 0xf, true));
        const unsigned w = odd ? cvt_pk_bf16(rcv, b) : cvt_pk_bf16(a, rcv);
        *(unsigned*)(Ow + eoff + d0 * 512) = w; } } }
  __syncthreads();
#undef SLOAD
#undef SWRITE
#undef SWAIT
#undef RESC
}
}

#define XB_TMO      128
#define XB_XCNT(j)  (256  + 64 * (j))
#define XB_XSUB(j)  (1280 + 64 * (j))
#define XB_XGEN(j)  (2304 + 64 * (j))
#define XB_TOP      3328
#define XB_TOPGEN   3392
#define XCD_BAR_WORDS 3456
#define XB_SPIN_CAP (1u << 18)
__device__ __forceinline__ unsigned xb_ld(unsigned* p)              { return __hip_atomic_load(p, __ATOMIC_RELAXED, __HIP_MEMORY_SCOPE_AGENT); }
__device__ __forceinline__ unsigned xb_add(unsigned* p, unsigned v) { return __hip_atomic_fetch_add(p, v, __ATOMIC_RELAXED, __HIP_MEMORY_SCOPE_AGENT); }
__device__ __forceinline__ unsigned xb_xcc_id() { return (unsigned)__builtin_amdgcn_s_getreg((3 << 11) | 20) & 0xFu; }
#define XB_SPIN(cond, bar) do { unsigned _sp = 0; while (cond) { __builtin_amdgcn_s_sleep(1); \
    if ((++_sp & 255u) == 0u) { if (xb_ld(&(bar)[XB_TMO])) break; if (_sp > XB_SPIN_CAP) { atomicAdd(&(bar)[XB_TMO], 1u); break; } } } } while (0)
struct XcdBarrier { unsigned* bar; unsigned x; volatile LAS unsigned* st; };
__device__ __forceinline__ XcdBarrier xcd_barrier_post(unsigned* bar, volatile LAS unsigned* st) {
    XcdBarrier b; b.bar = bar; b.x = xb_xcc_id(); b.st = st;
    if (threadIdx.x == 0) (void)xb_add(&bar[XB_XCNT(b.x)], 1u);
    return b;
}
__device__ __forceinline__ void xcd_barrier_complete(unsigned* bar, unsigned x, unsigned& nloc, unsigned& nx) {
    const unsigned G = gridDim.x * gridDim.y * gridDim.z;
    unsigned sum, cnt, mine, sp = 0u;
    for (;;) {
        sum = 0u; cnt = 0u; mine = 0u;
#pragma unroll
        for (unsigned j = 0; j < 16; ++j) { const unsigned c = xb_ld(&bar[XB_XCNT(j)]); sum += c; cnt += (c > 0u) ? 1u : 0u; mine = (j == x) ? c : mine; }
        if (sum == G) break;
        __builtin_amdgcn_s_sleep(1);
        if ((++sp & 255u) == 0u) { if (xb_ld(&bar[XB_TMO])) break; if (sp > XB_SPIN_CAP) { atomicAdd(&bar[XB_TMO], 1u); break; } }
    }
    nloc = mine > 0u ? mine : 1u; nx = cnt > 0u ? cnt : 1u;
}
__device__ __forceinline__ void xcd_barrier(const XcdBarrier& b) {
    asm volatile("s_waitcnt vmcnt(0)" ::: "memory");
    __syncthreads();
    if (threadIdx.x == 0) {
        unsigned* bar = b.bar;
        __builtin_amdgcn_s_waitcnt(0);
        unsigned nloc = b.st[0], nx = b.st[1];
        if (nloc == 0u) { xcd_barrier_complete(bar, b.x, nloc, nx); b.st[0] = nloc; b.st[1] = nx; }
        const unsigned old = xb_add(&bar[XB_XSUB(b.x)], 1u);
        const unsigned gen = old / nloc;
        if (old + 1u == (gen + 1u) * nloc) {
            __builtin_amdgcn_fence(__ATOMIC_RELEASE, "agent");
            asm volatile("s_waitcnt vmcnt(0)" ::: "memory");
            const unsigned og = xb_add(&bar[XB_TOP], 1u);
            const unsigned tg = og / nx;
            if (og + 1u == (tg + 1u) * nx) xb_add(&bar[XB_TOPGEN], 1u);
            else XB_SPIN(xb_ld(&bar[XB_TOPGEN]) == tg, bar);
            __builtin_amdgcn_fence(__ATOMIC_ACQUIRE, "agent");
            xb_add(&bar[XB_XGEN(b.x)], 1u);
            asm volatile("s_waitcnt vmcnt(0)" ::: "memory");
        } else {
            XB_SPIN(xb_ld(&bar[XB_XGEN(b.x)]) == gen, bar);
            __builtin_amdgcn_fence(__ATOMIC_ACQUIRE, "agent");
            asm volatile("s_waitcnt vmcnt(0)" ::: "memory");
        }
    }
    __syncthreads();
}

struct Args { const float* in[19]; float* out; unsigned char* ws; int ph_lo, ph_hi; };
enum { IN_XP = 0, IN_XS, IN_MEMP, IN_MEMS, IN_ATT_WIN, IN_QGAIN, IN_KGAIN, IN_ATT_WOUT, IN_ML_WIN, IN_ML_BGATE, IN_ML_HGAIN, IN_ML_WOUT, IN_XA_WQ, IN_XA_WKV, IN_XA_WOUT, IN_W1, IN_W2, IN_LNG, IN_LNB };
constexpr int MLP_NB = 1, PH_LAYER0 = 2, SLOTS = 14 + 2 * MLP_NB + 1, PH_FINAL = PH_LAYER0 + 4 * SLOTS, PH_END = PH_FINAL + 1;

struct TJob { const float* W; int K, N, ldw; bf16_t* dst; const float* g; const float* b; f32x2* cpart; int qkperm; int nat; };
typedef const __attribute__((address_space(4))) Args* KArgsT;
__device__ __forceinline__ void make_tjob(int j, KArgsT ap, TJob& J) {
    unsigned char* ws = ap->ws; const float* lng = ap->in[IN_LNG]; const float* lnb = ap->in[IN_LNB];
    f32x2* cp = (f32x2*)(ws + S_CPART); J.g = nullptr; J.b = nullptr; J.cpart = nullptr; J.qkperm = (j < 2) ? 1 : 0; J.nat = (j >= 8 && j < 12) ? 1 : 0;
    int lnidx = -1, cv = 0;
    if (j < 2)       { const int q = j;      J.W = ap->in[IN_ATT_WIN] + (size_t)q * DM * ATT_IN; J.K = DM; J.N = ATT_IN; J.ldw = ATT_IN; J.dst = (bf16_t*)(ws + W_ATT_IN) + (size_t)q * ATT_IN * DM; if (q == 1) { lnidx = 1 * 3 + 2; cv = CV_ATT_IN; } }
    else if (j < 4)  { const int q = j - 2;  J.W = ap->in[IN_ATT_WOUT] + (size_t)q * DM * DM; J.K = DM; J.N = DM; J.ldw = DM; J.dst = (bf16_t*)(ws + W_ATT_OUT) + (size_t)q * DM * DM; }
    else if (j < 6)  { const int q = j - 4;  J.W = ap->in[IN_ML_WIN] + (size_t)q * DM * ML_IN; J.K = DM; J.N = ML_IN; J.ldw = ML_IN; J.dst = (bf16_t*)(ws + W_ML_IN + (size_t)q * 25 * MiB); lnidx = (2 * q) * 3 + 2; cv = CV_ML_IN + q * ML_IN; }
    else if (j < 8)  { const int q = j - 6;  J.W = ap->in[IN_ML_WOUT] + (size_t)q * DM * DM; J.K = DM; J.N = DM; J.ldw = DM; J.dst = (bf16_t*)(ws + W_ML_OUT) + (size_t)q * DM * DM; }
    else if (j < 12) { const int q = j - 8;  J.W = ap->in[IN_XA_WQ] + (size_t)q * DM * DM; J.K = DM; J.N = DM; J.ldw = DM; J.dst = (bf16_t*)(ws + W_XA_Q) + (size_t)q * DM * DM; lnidx = q * 3 + 0; cv = CV_XAQ + q * DM; }
    else if (j < 16) { const int q = j - 12; J.W = ap->in[IN_XA_WKV] + (size_t)q * DM * 4096; J.K = DM; J.N = DM; J.ldw = 4096; J.dst = (bf16_t*)(ws + S_WKT) + (size_t)q * DM * DM; }
    else if (j < 20) { const int q = j - 16; J.W = ap->in[IN_XA_WKV] + (size_t)q * DM * 4096 + 2048; J.K = DM; J.N = DM; J.ldw = 4096; J.dst = (bf16_t*)(ws + S_WVT) + (size_t)q * DM * DM; }
    else if (j < 24) { const int q = j - 20; J.W = ap->in[IN_XA_WOUT] + (size_t)q * DM * DM; J.K = DM; J.N = DM; J.ldw = DM; J.dst = (bf16_t*)(ws + W_XA_OUT) + (size_t)q * DM * DM; }
    else if (j < 28) { const int q = j - 24; J.W = ap->in[IN_W1] + (size_t)q * DM * DFF; J.K = DM; J.N = DFF; J.ldw = DFF; J.dst = (bf16_t*)(ws + W_W1) + (size_t)q * DFF * DM; lnidx = q * 3 + 1; cv = CV_W1 + q * DFF; }
    else             { const int q = j - 28; J.W = ap->in[IN_W2] + (size_t)q * DFF * DM; J.K = DFF; J.N = DM; J.ldw = DM; J.dst = (bf16_t*)(ws + W_W2) + (size_t)q * DM * DFF; }
    if (lnidx >= 0) { J.g = lng + lnidx * DM; J.b = lnb + lnidx * DM; J.cpart = cp + (size_t)cv * 32; }
}
constexpr int N_TJOBS = 32;
__host__ __device__ __forceinline__ int qk_slot(int n) {
    if (n >= 2560) return n;
    const int e = n & 127, sec = e >> 6, w6 = e & 63, half = w6 >> 5, x1 = w6 & 31;
    return (n & ~127) | ((sec * 2 + (x1 >> 4)) << 5) | (((x1 >> 2) & 3) << 3) | (half << 2) | (x1 & 3);
}
__device__ __forceinline__ void transpose_item(const TJob& J, LAS float* scr, int item, int lane) {
    const int nblk = J.N / 32, kb = item / nblk, nb = item % nblk, k0 = 64 * kb, n0 = 32 * nb;
#pragma unroll
    for (int i = 0; i < 8; ++i) { const int kk = 8 * i + (lane >> 3), c4 = (lane & 7) * 4; const f32x4 v = *(const f32x4*)(J.W + (size_t)(k0 + kk) * J.ldw + n0 + c4);
        LAS float* d = scr + kk * 33 + c4; d[0] = v[0]; d[1] = v[1]; d[2] = v[2]; d[3] = v[3]; }
    LDS_WAIT(); asm volatile("" ::: "memory");
    const int c = lane & 7;
    float gk[8], bk[8];
    const bool fold = (J.g != nullptr);
#pragma unroll
    for (int i = 0; i < 8; ++i) { gk[i] = fold ? J.g[k0 + 8 * c + i] : 1.f; bk[i] = fold ? J.b[k0 + 8 * c + i] : 0.f; }
#pragma unroll
    for (int j = 0; j < 4; ++j) { const int n = (lane >> 3) + 8 * j; const LAS float* s = scr + (8 * c) * 33 + n;
        unsigned bits[8]; float c1p = 0.f, c2p = 0.f;
#pragma unroll
        for (int i = 0; i < 8; ++i) { const float w = s[i * 33]; bits[i] = f2bf(w * gk[i]); c1p += bf2f(bits[i]); c2p += bk[i] * w; }
        u32x4 o; o.x = bits[0] | (bits[1] << 16); o.y = bits[2] | (bits[3] << 16); o.z = bits[4] | (bits[5] << 16); o.w = bits[6] | (bits[7] << 16);
        const int drow = J.qkperm ? qk_slot(n0 + n) : n0 + n;
        *(u32x4*)(J.dst + (size_t)drow * J.K + k0 + 8 * c) = o;
        if (fold) {
            c1p = sum8(c1p); c2p = sum8(c2p);
            if (c == 0) J.cpart[(size_t)kb * J.N + drow] = (f32x2){c1p, c2p}; } }
    LDS_WAIT(); asm volatile("" ::: "memory");
}
__device__ __forceinline__ void convert_item(const TJob& J, int item, int lane) {
    const int nblk = J.N / 128, kb = item / nblk, nb = item % nblk, k0 = 64 * kb, n0 = 128 * nb + 2 * lane;
    float c1a = 0.f, c1b = 0.f, c2a = 0.f, c2b = 0.f;
#pragma unroll 8
    for (int k = 0; k < 64; ++k) { const f32x2 wv = *(const f32x2*)(J.W + (size_t)(k0 + k) * J.ldw + n0); const float gk = J.g ? J.g[k0 + k] : 1.f, bk = J.b ? J.b[k0 + k] : 0.f;
        const unsigned ba = f2bf(wv.x * gk), bb = f2bf(wv.y * gk); *(unsigned*)(J.dst + (size_t)(k0 + k) * J.N + n0) = ba | (bb << 16);
        c1a += bf2f(ba); c1b += bf2f(bb); c2a += bk * wv.x; c2b += bk * wv.y; }
    if (J.cpart) { J.cpart[(size_t)kb * J.N + n0] = (f32x2){c1a, c2a}; J.cpart[(size_t)kb * J.N + n0 + 1] = (f32x2){c1b, c2b}; }
}
__device__ __forceinline__ void cvt_rows(const float* src, bf16_t* dst, size_t n8, size_t gtid, size_t gthreads) {
    for (size_t i = gtid; i < n8; i += gthreads) { const f32x4 a = *(const f32x4*)(src + i * 8), b = *(const f32x4*)(src + i * 8 + 4);
        u32x4 w; w.x = cvt_pk_bf16(a[0], a[1]); w.y = cvt_pk_bf16(a[2], a[3]); w.z = cvt_pk_bf16(b[0], b[1]); w.w = cvt_pk_bf16(b[2], b[3]); *(u32x4*)(dst + i * 8) = w; }
}

__device__ __forceinline__ void cvt_rows_tiled(const float* src, bf16_t* dst, size_t n8, size_t gtid, size_t gthreads) {
    for (size_t i0 = gtid; i0 < n8; i0 += 4 * gthreads) { f32x4 a[4], b[4];
#pragma unroll
        for (int q = 0; q < 4; ++q) { const size_t i = i0 + q * gthreads, blk = i >> 6; const int w = (int)(i & 63), rl = w >> 2, c8 = (w & 3) * 8;
            const size_t rb = blk / (DM / 32); const int cb = (int)(blk % (DM / 32)); const float* s = src + (rb * 16 + rl) * DM + cb * 32 + c8;
            a[q] = *(const f32x4*)s; b[q] = *(const f32x4*)(s + 4); }
#pragma unroll
        for (int q = 0; q < 4; ++q) { const size_t i = i0 + q * gthreads;
            u32x4 wv; wv.x = cvt_pk_bf16(a[q][0], a[q][1]); wv.y = cvt_pk_bf16(a[q][2], a[q][3]); wv.z = cvt_pk_bf16(b[q][0], b[q][1]); wv.w = cvt_pk_bf16(b[q][2], b[q][3]); *(u32x4*)(dst + i * 8) = wv; } }
}

constexpr int SC_T = 16;
constexpr int SC_BUF = SC_T * 128 * 4 * 2 + SC_T * 64 * 4 + SC_T * 8 + SC_T * 64 * 4;
__device__ __forceinline__ void scan_item(const bf16_t* __restrict__ hq, const bf16_t* __restrict__ hk, const bf16_t* __restrict__ hv, const float* __restrict__ gi, const float* __restrict__ gf,
                                          float* __restrict__ hout, int S, int dir, char* lds) {
    const int tid = opaque_tid(), dv = tid >> 3, part = tid & 7, sub = dv & 7;
    float C[16]; float n0 = 0.f, n1 = 0.f, m = 0.f;
#pragma unroll
    for (int i = 0; i < 16; ++i) C[i] = 0.f;
    const int nblk = S / SC_T;
    const int ra = (tid & 255) >> 4, ca = tid & 15; const bool isk = tid >= 256;
    const int rb = tid >> 3, cb = tid & 7;
    bf16x8 sa, sb; float sgi = 0.f, sgf = 0.f;
#define SC_POS(blk, t) (dir ? (S - 1 - ((blk) * SC_T + (t))) : ((blk) * SC_T + (t)))
#define SC_LOAD(blk) do { { const long p = SC_POS(blk, ra); sa = *(const bf16x8*)((isk ? hk : hq) + p * ML_MAIN + ca * 8); } \
        if (tid < 128) { const long p = SC_POS(blk, rb); sb = *(const bf16x8*)(hv + p * ML_MAIN + cb * 8); } \
        if (tid < SC_T) { const long p = SC_POS(blk, tid); sgi = gi[p * 32]; sgf = gf[p * 32]; } } while (0)
#define SC_WRITE(buf) do { char* B_ = lds + (buf) * SC_BUF; float* dst_ = (float*)(B_ + (isk ? 8192 : 0)) + ra * 128 + ca * 8; const float sc_ = isk ? 0.088388347648318440f : 1.f; \
        f32x4 lo_, hi_; _Pragma("unroll") for (int e = 0; e < 4; ++e) { lo_[e] = bf2f((unsigned short)sa[e]) * sc_; hi_[e] = bf2f((unsigned short)sa[4 + e]) * sc_; } \
        *(f32x4*)dst_ = lo_; *(f32x4*)(dst_ + 4) = hi_; \
        if (tid < 128) { float* dv_ = (float*)(B_ + 16384) + rb * 64 + cb * 8; f32x4 l2_, h2_; _Pragma("unroll") for (int e = 0; e < 4; ++e) { l2_[e] = bf2f((unsigned short)sb[e]); h2_[e] = bf2f((unsigned short)sb[4 + e]); } \
            *(f32x4*)dv_ = l2_; *(f32x4*)(dv_ + 4) = h2_; } \
        if (tid < SC_T) { float* dg_ = (float*)(B_ + 16384 + 4096) + tid * 2; const float x_ = sgf; const float lf_ = fminf(x_, 0.f) - __logf(1.f + __expf(-fabsf(x_))); dg_[0] = sgi; dg_[1] = lf_; } } while (0)
    SC_LOAD(0); SC_WRITE(0); __syncthreads();
    for (int blk = 0; blk < nblk; ++blk) {
        const int cur = blk & 1;
        if (blk + 1 < nblk) SC_LOAD(blk + 1);
        const char* B = lds + cur * SC_BUF; const float* ql = (const float*)B; const float* kl = (const float*)(B + 8192); const float* vl = (const float*)(B + 16384); const float* gl = (const float*)(B + 16384 + 4096);
        float* hb = (float*)(B + 16384 + 4096 + 128);
#pragma unroll 2
        for (int t = 0; t < SC_T; ++t) {
            f32x4 q4[4], k4[4];
#pragma unroll
            for (int e = 0; e < 4; ++e) { q4[e] = *(const f32x4*)(ql + t * 128 + part * 16 + e * 4); k4[e] = *(const f32x4*)(kl + t * 128 + part * 16 + e * 4); }
            const f32x2 qn = *(const f32x2*)(ql + t * 128 + part * 16 + sub * 2), kn = *(const f32x2*)(kl + t * 128 + part * 16 + sub * 2);
            const float vt = vl[t * 64 + dv]; const float li = gl[t * 2], lf = gl[t * 2 + 1];
            const float mn = fmaxf(lf + m, li); const float fp = __expf(lf + m - mn), ip = __expf(li - mn); m = mn;
            const float iv = ip * vt; float hp = 0.f;
#pragma unroll
            for (int e = 0; e < 4; ++e)
#pragma unroll
                for (int x = 0; x < 4; ++x) { C[e * 4 + x] = fp * C[e * 4 + x] + iv * k4[e][x]; hp += C[e * 4 + x] * q4[e][x]; }
            n0 = fp * n0 + ip * kn.x; n1 = fp * n1 + ip * kn.y; float dp = n0 * qn.x + n1 * qn.y;
            hp += __shfl_xor(hp, 1); hp += __shfl_xor(hp, 2); hp += __shfl_xor(hp, 4);
            dp = wave_sum(dp);
            const float den = fmaxf(fabsf(dp), __expf(-m));
            if (part == 0) hb[t * 64 + dv] = hp / den;
        }
        if (blk + 1 < nblk) SC_WRITE(cur ^ 1);
        __syncthreads();
        if (tid < 256) { const int t = tid >> 4, c4 = tid & 15; const long p = SC_POS(blk, t); *(f32x4*)(hout + p * DM + c4 * 4) = *(const f32x4*)(hb + t * 64 + c4 * 4); }
    }
    __syncthreads();
#undef SC_POS
#undef SC_LOAD
#undef SC_WRITE
}

namespace ms {
constexpr int L_QS = 0, L_KS = 16384, L_KW = 32768, L_V = 49152, L_SB = 65536, L_CB = 81920, L_VEC = 98304, VEC_STRIDE = 1536;
constexpr int L_N = L_VEC + 2 * VEC_STRIDE, L_NQ = L_N + 512, L_DENP = L_NQ + 256, L_END = L_DENP + 512;
typedef short v4i16_t __attribute__((ext_vector_type(4)));
__device__ __forceinline__ unsigned offb(unsigned row, unsigned ch) { return 256u * row + 16u * (ch ^ (((row & 3) << 2) | ((row >> 2) & 3))); }
__device__ __forceinline__ bf16x8 rowfrag(LAS const unsigned char* img, int row, int kstep, int lane) { return *(const LAS bf16x8*)(img + offb(row, 4 * kstep + (lane >> 4))); }
__device__ __forceinline__ bf16x8 trfrag(LAS const unsigned char* img, int c, int ks, int lane) {
    const unsigned g = lane >> 4, q = (lane & 15) >> 2, p = lane & 3;
    const v4i16_t t0 = __builtin_amdgcn_ds_read_tr16_b64_v4i16((LAS v4i16_t*)(img + offb(32 * ks + 8 * g + q, 2 * c + (p >> 1)) + 8 * (p & 1)));
    const v4i16_t t1 = __builtin_amdgcn_ds_read_tr16_b64_v4i16((LAS v4i16_t*)(img + offb(32 * ks + 8 * g + 4 + q, 2 * c + (p >> 1)) + 8 * (p & 1)));
    return (bf16x8){t0[0], t0[1], t0[2], t0[3], t1[0], t1[1], t1[2], t1[3]};
}
__device__ __forceinline__ void scan_item(const bf16_t* __restrict__ hq, const bf16_t* __restrict__ hk, const bf16_t* __restrict__ hv, const float* __restrict__ gi, const float* __restrict__ gf,
                                          float* __restrict__ hout, int S, int dir, LAS unsigned char* L) {
    const int tid = opaque_tid(), lane = tid & 63, w = __builtin_amdgcn_readfirstlane(tid >> 6);
    const int nch = S >> 6;
    LAS unsigned char* Qs = L + L_QS; LAS unsigned char* Ks = L + L_KS; LAS unsigned char* Kw = L + L_KW; LAS unsigned char* Vi = L + L_V; LAS unsigned char* Sb = L + L_SB; LAS unsigned char* Cb = L + L_CB;
    LAS float* nv = (LAS float*)(L + L_N); LAS float* nq = (LAS float*)(L + L_NQ); LAS float* denp = (LAS float*)(L + L_DENP);
    f32x4 Cacc[4];
#pragma unroll
    for (int i = 0; i < 4; ++i) Cacc[i] = (f32x4){0.f, 0.f, 0.f, 0.f};
    float m = 0.f;
    { const u32x4 zz = {0u, 0u, 0u, 0u}; *(LAS u32x4*)(Cb + tid * 32) = zz; *(LAS u32x4*)(Cb + tid * 32 + 16) = zz; if (tid < 128) nv[tid] = 0.f; }
    bf16x8 rq[2], rk[2], rv; float rgi = 0.f, rgf = 0.f;
#define MS_POS(j, row) (dir ? (S - 1 - ((j) * 64 + (row))) : ((j) * 64 + (row)))
#define MS_LOAD(j) do { _Pragma("unroll") for (int i_ = 0; i_ < 2; ++i_) { const int pi_ = tid + 512 * i_; const long p_ = MS_POS(j, pi_ >> 4); \
            rq[i_] = *(const bf16x8*)(hq + p_ * ML_MAIN + (pi_ & 15) * 8); rk[i_] = *(const bf16x8*)(hk + p_ * ML_MAIN + (pi_ & 15) * 8); } \
        { const long p_ = MS_POS(j, tid >> 3); rv = *(const bf16x8*)(hv + p_ * ML_MAIN + (tid & 7) * 8); } \
        if (w == 0) { const long p_ = MS_POS(j, lane); rgi = gi[p_ * 32]; rgf = gf[p_ * 32]; } } while (0)
#define MS_VEC(vb) do { if (w == 0) { LAS float* V_ = (LAS float*)(L + L_VEC + (vb) * VEC_STRIDE); const float xf_ = rgf; const float lf_ = fminf(xf_, 0.f) - __logf(1.f + __expf(-fabsf(xf_))); \
        const float b_ = scan_add(lf_); const float a_ = rgi - b_; const float pm_ = scan_max(a_); \
        const float M_ = fmaxf(m, pm_); const float M63_ = __int_as_float(__builtin_amdgcn_readlane(__float_as_int(M_), 63)), bL_ = __int_as_float(__builtin_amdgcn_readlane(__float_as_int(b_), 63)); \
        V_[lane] = a_; V_[64 + lane] = M_; V_[128 + lane] = __expf(m - M_); V_[192 + lane] = __expf(-(b_ + M_)); V_[256 + lane] = __expf(a_ - M63_); if (lane == 0) V_[320] = __expf(m - M63_); \
        m = bL_ + M63_; } } while (0)
#define MS_STAGE(vb) do { LAS const float* V_ = (LAS const float*)(L + L_VEC + (vb) * VEC_STRIDE); \
        _Pragma("unroll") for (int i_ = 0; i_ < 2; ++i_) { const int pi_ = tid + 512 * i_, row_ = pi_ >> 4, ch_ = pi_ & 15; const unsigned o_ = offb(row_, ch_); \
            *(LAS bf16x8*)(Qs + o_) = rq[i_]; const float ws_ = V_[256 + row_]; u32x4 k0_, k1_; \
            float kf_[8]; _Pragma("unroll") for (int e_ = 0; e_ < 8; ++e_) kf_[e_] = bf2f((unsigned short)rk[i_][e_]) * 0.088388347648318440f; \
            k0_.x = cvt_pk_bf16(kf_[0], kf_[1]); k0_.y = cvt_pk_bf16(kf_[2], kf_[3]); k0_.z = cvt_pk_bf16(kf_[4], kf_[5]); k0_.w = cvt_pk_bf16(kf_[6], kf_[7]); \
            k1_.x = cvt_pk_bf16(kf_[0] * ws_, kf_[1] * ws_); k1_.y = cvt_pk_bf16(kf_[2] * ws_, kf_[3] * ws_); k1_.z = cvt_pk_bf16(kf_[4] * ws_, kf_[5] * ws_); k1_.w = cvt_pk_bf16(kf_[6] * ws_, kf_[7] * ws_); \
            *(LAS u32x4*)(Ks + o_) = k0_; *(LAS u32x4*)(Kw + o_) = k1_; } \
        *(LAS bf16x8*)(Vi + offb(tid >> 3, tid & 7)) = rv; } while (0)
    MS_LOAD(0); MS_VEC(0);
    __syncthreads();
    MS_STAGE(0);
    const int tl = w >> 1, th = w & 1, lr = lane & 15, lg = lane >> 4;
    for (int j = 0; j < nch; ++j) {
        const int vb = j & 1;
        LAS const float* V = (LAS const float*)(L + L_VEC + vb * VEC_STRIDE);
        __syncthreads();
        if (j + 1 < nch) MS_LOAD(j + 1);
        { const int l = tid >> 3, part = tid & 7;
          const bf16x8 q0 = *(const LAS bf16x8*)(Qs + offb(l, 2 * part)), q1 = *(const LAS bf16x8*)(Qs + offb(l, 2 * part + 1));
          float s = 0.f;
#pragma unroll
          for (int e = 0; e < 8; ++e) { s += bf2f((unsigned short)q0[e]) * nv[part * 16 + e]; s += bf2f((unsigned short)q1[e]) * nv[part * 16 + 8 + e]; }
          s = sum8(s);
          if (part == 0) nq[l] = s; }
        bf16x8 qf[4];
#pragma unroll
        for (int kk = 0; kk < 4; ++kk) qf[kk] = rowfrag(Qs, 16 * tl + lr, kk, lane);
        f32x4 acc3[2];
        { const int l = 16 * tl + lr; const float Ml = V[64 + l]; float rs = 0.f;
#pragma unroll
          for (int i = 0; i < 2; ++i) { const int ts = 2 * th + i; f32x4 sv = {0.f, 0.f, 0.f, 0.f};
              if (ts <= tl) { f32x4 acc = {0.f, 0.f, 0.f, 0.f};
#pragma unroll
                  for (int kk = 0; kk < 4; ++kk) acc = __builtin_amdgcn_mfma_f32_16x16x32_bf16(rowfrag(Ks, 16 * ts + lr, kk, lane), qf[kk], acc, 0, 0, 0);
                  const f32x4 a4 = *(const LAS f32x4*)(V + 16 * ts + 4 * lg);
#pragma unroll
                  for (int r = 0; r < 4; ++r) { const int s = 16 * ts + 4 * lg + r; sv[r] = (s <= l) ? acc[r] * __expf(a4[r] - Ml) : 0.f; } }
              u32x2 pk; pk.x = cvt_pk_bf16(sv[0], sv[1]); pk.y = cvt_pk_bf16(sv[2], sv[3]);
              const int s0 = 16 * ts + 4 * lg; *(LAS u32x2*)(Sb + offb(l, s0 >> 3) + 2 * (s0 & 7)) = pk;
              rs += (sv[0] + sv[1]) + (sv[2] + sv[3]); }
          rs = sum_x32(sum_x16(rs));
          if (lane < 16) denp[l * 2 + th] = rs; }
#pragma unroll
        for (int i = 0; i < 2; ++i) { const int tdv = 2 * th + i; f32x4 acc = {0.f, 0.f, 0.f, 0.f};
#pragma unroll
            for (int kk = 0; kk < 4; ++kk) acc = __builtin_amdgcn_mfma_f32_16x16x32_bf16(qf[kk], rowfrag(Cb, 16 * tdv + lr, kk, lane), acc, 0, 0, 0);
            acc3[i] = acc; }
        __syncthreads();
        bf16x8 vf[4][2];
#pragma unroll
        for (int c = 0; c < 4; ++c)
#pragma unroll
            for (int ks = 0; ks < 2; ++ks) vf[c][ks] = trfrag(Vi, c, ks, lane);
        { const int l0 = 16 * tl + 4 * lg;
          const f32x4 g4 = *(const LAS f32x4*)(V + 128 + l0), fl4 = *(const LAS f32x4*)(V + 192 + l0), nq4 = *(const LAS f32x4*)(nq + l0);
          const f32x4 dp0 = *(const LAS f32x4*)(denp + l0 * 2), dp1 = *(const LAS f32x4*)(denp + l0 * 2 + 4);
          f32x4 inv;
          inv[0] = __builtin_amdgcn_rcpf(fmaxf(fabsf(g4[0] * nq4[0] + dp0[0] + dp0[1]), fl4[0])); inv[1] = __builtin_amdgcn_rcpf(fmaxf(fabsf(g4[1] * nq4[1] + dp0[2] + dp0[3]), fl4[1]));
          inv[2] = __builtin_amdgcn_rcpf(fmaxf(fabsf(g4[2] * nq4[2] + dp1[0] + dp1[1]), fl4[2])); inv[3] = __builtin_amdgcn_rcpf(fmaxf(fabsf(g4[3] * nq4[3] + dp1[2] + dp1[3]), fl4[3]));
          const bf16x8 sf0 = rowfrag(Sb, 16 * tl + lr, 0, lane), sf1 = rowfrag(Sb, 16 * tl + lr, 1, lane);
#pragma unroll
          for (int i = 0; i < 2; ++i) { const int tdv = 2 * th + i; f32x4 acc = acc3[i] * g4;
              acc = __builtin_amdgcn_mfma_f32_16x16x32_bf16(sf0, trfrag(Vi, tdv, 0, lane), acc, 0, 0, 0);
              acc = __builtin_amdgcn_mfma_f32_16x16x32_bf16(sf1, trfrag(Vi, tdv, 1, lane), acc, 0, 0, 0);
#pragma unroll
              for (int r = 0; r < 4; ++r) { const long p = MS_POS(j, l0 + r); hout[p * DM + 16 * tdv + lr] = acc[r] * inv[r]; } } }
        { const float gs = V[320];
          const bf16x8 ak0 = trfrag(Kw, w, 0, lane), ak1 = trfrag(Kw, w, 1, lane);
#pragma unroll
          for (int c = 0; c < 4; ++c) { f32x4 acc = Cacc[c] * gs;
              acc = __builtin_amdgcn_mfma_f32_16x16x32_bf16(ak0, vf[c][0], acc, 0, 0, 0);
              acc = __builtin_amdgcn_mfma_f32_16x16x32_bf16(ak1, vf[c][1], acc, 0, 0, 0);
              Cacc[c] = acc;
              u32x2 pk; pk.x = cvt_pk_bf16(acc[0], acc[1]); pk.y = cvt_pk_bf16(acc[2], acc[3]);
              const int dk0 = 16 * w + 4 * lg; *(LAS u32x2*)(Cb + offb(16 * c + lr, dk0 >> 3) + 2 * (dk0 & 7)) = pk; }
          if (tid < 128) { float a = gs * nv[tid];
#pragma unroll 8
              for (int s = 0; s < 64; ++s) a += bf2f(*(const LAS unsigned short*)(Kw + offb(s, tid >> 3) + 2 * (tid & 7)));
              nv[tid] = a; } }
        if (j + 1 < nch) MS_VEC(vb ^ 1);
        __syncthreads();
        if (j + 1 < nch) MS_STAGE(vb ^ 1);
    }
    __syncthreads();
#undef MS_POS
#undef MS_LOAD
#undef MS_VEC
#undef MS_STAGE
}
}

namespace ms2 {
using ms::offb; using ms::rowfrag; using ms::trfrag; using ms::v4i16_t;
constexpr int IMG = 16384, L_QS = 0, L_KW = 2 * IMG, L_V = 4 * IMG, L_CB = 6 * IMG;
constexpr int L_NV = LDS_XL, L_TAB = LDS_XL + 1024, L_SCR = LDS_XL + 2048;
__device__ __forceinline__ float bperm(float v, int srclane) { return __int_as_float(__builtin_amdgcn_ds_bpermute(srclane << 2, __float_as_int(v))); }
__device__ __forceinline__ bf16x8 trfrag_perm(LAS const unsigned char* img, int c, int ks, int lane) {
    const unsigned g = lane >> 4, q = (lane & 15) >> 2, p = lane & 3;
    const v4i16_t t0 = __builtin_amdgcn_ds_read_tr16_b64_v4i16((LAS v4i16_t*)(img + offb(32 * ks + 4 * g + q, 2 * c + (p >> 1)) + 8 * (p & 1)));
    const v4i16_t t1 = __builtin_amdgcn_ds_read_tr16_b64_v4i16((LAS v4i16_t*)(img + offb(32 * ks + 16 + 4 * g + q, 2 * c + (p >> 1)) + 8 * (p & 1)));
    return (bf16x8){t0[0], t0[1], t0[2], t0[3], t1[0], t1[1], t1[2], t1[3]};
}
__device__ __forceinline__ float logsig(float x) { return fminf(x, 0.f) - __logf(1.f + __expf(-fabsf(x))); }
__device__ __forceinline__ void scan_item(const bf16_t* __restrict__ hq, const bf16_t* __restrict__ hk, const bf16_t* __restrict__ hv, const float* __restrict__ gi, const float* __restrict__ gf,
                                          float* __restrict__ hout, int S, int dir, LAS unsigned char* L) {
    const int tid = opaque_tid(), lane = tid & 63, w = __builtin_amdgcn_readfirstlane(tid >> 6);
    const int nch = S >> 6, tl = w >> 1, th = w & 1, lr = lane & 15, lg = lane >> 4;
    LAS float* nvb = (LAS float*)(L + L_NV); LAS float* bLt = (LAS float*)(L + L_TAB); LAS float* pmLt = bLt + 64; LAS float* mtab = bLt + 128; LAS float* scr = (LAS float*)(L + L_SCR) + w * 16;
#define MS_POS(j, row) (dir ? (S - 1 - ((j) * 64 + (row))) : ((j) * 64 + (row)))
    { const u32x4 zz = {0u, 0u, 0u, 0u}; *(LAS u32x4*)(L + L_CB + tid * 32) = zz; *(LAS u32x4*)(L + L_CB + tid * 32 + 16) = zz; if (tid < 128) nvb[tid] = 0.f; }
    for (int c = w; c < nch; c += 8) { const long p = MS_POS(c, lane); const float li = gi[p * 32], lf = logsig(gf[p * 32]);
        const float b = scan_add(lf), pm = scan_max(li - b); if (lane == 63) { bLt[c] = b; pmLt[c] = pm; } }
    __syncthreads();
    if (tid == 0) { float m = 0.f; for (int c = 0; c < nch; ++c) { mtab[c] = m; m = bLt[c] + fmaxf(m, pmLt[c]); } }
    __syncthreads();
    f32x4 Cacc[4], nacc = {0.f, 0.f, 0.f, 0.f};
#pragma unroll
    for (int i = 0; i < 4; ++i) Cacc[i] = (f32x4){0.f, 0.f, 0.f, 0.f};
    const bf16x8 ones = {0x3F80, 0x3F80, 0x3F80, 0x3F80, 0x3F80, 0x3F80, 0x3F80, 0x3F80};
    bf16x8 rqA[2], rkA[2], rvA; float rgiA, rgfA;
    float va, vb, vpm;
#define MS_LOAD(j, X) do { _Pragma("unroll") for (int i_ = 0; i_ < 2; ++i_) { const int pi_ = tid + 512 * i_; const long p_ = MS_POS(j, pi_ >> 4); \
            rq##X[i_] = *(const bf16x8*)(hq + p_ * ML_MAIN + (pi_ & 15) * 8); rk##X[i_] = *(const bf16x8*)(hk + p_ * ML_MAIN + (pi_ & 15) * 8); } \
        { const long p_ = MS_POS(j, tid >> 3); rv##X = *(const bf16x8*)(hv + p_ * ML_MAIN + (tid & 7) * 8); } \
        { const long p_ = MS_POS(j, lane); rgi##X = gi[p_ * 32]; rgf##X = gf[p_ * 32]; } } while (0)
#define MS_STAGE(j, bf, X) do { { const float lf_ = logsig(rgf##X); vb = scan_add(lf_); va = rgi##X - vb; vpm = scan_max(va); } \
        const float M63_ = fmaxf(mtab[j], __int_as_float(__builtin_amdgcn_readlane(__float_as_int(vpm), 63))); const float wsl_ = __expf(va - M63_); \
        _Pragma("unroll") for (int i_ = 0; i_ < 2; ++i_) { const int pi_ = tid + 512 * i_, row_ = pi_ >> 4, ch_ = pi_ & 15; const unsigned o_ = offb(row_, ch_); \
            *(LAS bf16x8*)(L + L_QS + (bf) * IMG + o_) = rq##X[i_]; const float ws_ = bperm(wsl_, row_) * 0.088388347648318440f; u32x4 k1_; \
            float kf_[8]; _Pragma("unroll") for (int e_ = 0; e_ < 8; ++e_) kf_[e_] = bf2f((unsigned short)rk##X[i_][e_]) * ws_; \
            k1_.x = cvt_pk_bf16(kf_[0], kf_[1]); k1_.y = cvt_pk_bf16(kf_[2], kf_[3]); k1_.z = cvt_pk_bf16(kf_[4], kf_[5]); k1_.w = cvt_pk_bf16(kf_[6], kf_[7]); \
            *(LAS u32x4*)(L + L_KW + (bf) * IMG + o_) = k1_; } \
        *(LAS bf16x8*)(L + L_V + (bf) * IMG + offb(tid >> 3, tid & 7)) = rv##X; } while (0)
#define MS_SB() __builtin_amdgcn_sched_barrier(0)
#define MS_CHUNK(j) do { const int cur = (j) & 1, nxt = cur ^ 1; \
        LAS const unsigned char* Qs = L + L_QS + cur * IMG; LAS const unsigned char* Kw = L + L_KW + cur * IMG; LAS const unsigned char* Vi = L + L_V + cur * IMG; \
        LAS const unsigned char* Cbr = L + L_CB + cur * IMG; LAS unsigned char* Cbw = L + L_CB + nxt * IMG; LAS const float* nvr = nvb + cur * 128; LAS float* nvw = nvb + nxt * 128; \
        const float mt = mtab[j]; const float Mv = fmaxf(mt, vpm); const float M63 = __int_as_float(__builtin_amdgcn_readlane(__float_as_int(Mv), 63)); \
        const float Mcol = bperm(Mv, 16 * tl + lr), bcol = bperm(vb, 16 * tl + lr); \
        f32x4 m4; _Pragma("unroll") for (int r = 0; r < 4; ++r) m4[r] = bperm(Mv, 16 * tl + 4 * lg + r); \
          \
        bf16x8 qf[4], kwa[2][4]; f32x4 nn[8]; \
        _Pragma("unroll") for (int kk = 0; kk < 4; ++kk) qf[kk] = rowfrag(Qs, 16 * tl + lr, kk, lane); \
        _Pragma("unroll") for (int t = 0; t < 2; ++t) _Pragma("unroll") for (int kk = 0; kk < 4; ++kk) kwa[t][kk] = rowfrag(Kw, 16 * t + lr, kk, lane); \
        _Pragma("unroll") for (int kk = 0; kk < 4; ++kk) { nn[2 * kk] = *(const LAS f32x4*)(nvr + 32 * kk + 8 * lg); nn[2 * kk + 1] = *(const LAS f32x4*)(nvr + 32 * kk + 8 * lg + 4); } \
        MS_SB(); \
        const float colscale = __expf(M63 - Mcol), gs = __expf(mt - M63); \
        f32x4 g4; _Pragma("unroll") for (int r = 0; r < 4; ++r) g4[r] = __expf(mt - m4[r]); \
        f32x4 sacc[4]; \
        _Pragma("unroll") for (int t = 0; t < 2; ++t) { f32x4 acc = {0.f, 0.f, 0.f, 0.f}; \
            _Pragma("unroll") for (int kk = 0; kk < 4; ++kk) acc = __builtin_amdgcn_mfma_f32_16x16x32_bf16(kwa[t][kk], qf[kk], acc, 0, 0, 0); sacc[t] = acc; } \
        MS_SB(); \
          \
        bf16x8 kwb[2][4], cbf[2][4]; \
        _Pragma("unroll") for (int t = 0; t < 2; ++t) _Pragma("unroll") for (int kk = 0; kk < 4; ++kk) kwb[t][kk] = rowfrag(Kw, 32 + 16 * t + lr, kk, lane); \
        _Pragma("unroll") for (int i = 0; i < 2; ++i) _Pragma("unroll") for (int kk = 0; kk < 4; ++kk) cbf[i][kk] = rowfrag(Cbr, 16 * (2 * th + i) + lr, kk, lane); \
        MS_SB(); \
        float nqp = 0.f; \
        _Pragma("unroll") for (int kk = 0; kk < 4; ++kk) _Pragma("unroll") for (int e = 0; e < 4; ++e) { nqp += bf2f((unsigned short)qf[kk][e]) * nn[2 * kk][e]; nqp += bf2f((unsigned short)qf[kk][4 + e]) * nn[2 * kk + 1][e]; } \
        nqp = sum_x32(sum_x16(nqp)); \
        _Pragma("unroll") for (int t = 0; t < 2; ++t) { f32x4 acc = {0.f, 0.f, 0.f, 0.f}; \
            _Pragma("unroll") for (int kk = 0; kk < 4; ++kk) acc = __builtin_amdgcn_mfma_f32_16x16x32_bf16(kwb[t][kk], qf[kk], acc, 0, 0, 0); sacc[2 + t] = acc; } \
        f32x4 acc3[2]; \
        _Pragma("unroll") for (int i = 0; i < 2; ++i) { f32x4 acc = {0.f, 0.f, 0.f, 0.f}; \
            _Pragma("unroll") for (int kk = 0; kk < 4; ++kk) acc = __builtin_amdgcn_mfma_f32_16x16x32_bf16(qf[kk], cbf[i][kk], acc, 0, 0, 0); acc3[i] = acc * g4; } \
        MS_SB(); \
          \
        bf16x8 vp[2][2]; \
        _Pragma("unroll") for (int i = 0; i < 2; ++i) _Pragma("unroll") for (int ks = 0; ks < 2; ++ks) vp[i][ks] = trfrag_perm(Vi, 2 * th + i, ks, lane); \
        MS_SB(); \
          \
        u32x2 spk[4]; float rs = 0.f; const int l = 16 * tl + lr; \
        _Pragma("unroll") for (int ts = 0; ts < 4; ++ts) { f32x4 sv; \
            _Pragma("unroll") for (int r = 0; r < 4; ++r) { const int s = 16 * ts + 4 * lg + r; sv[r] = (s <= l) ? sacc[ts][r] * colscale : 0.f; } \
            spk[ts].x = cvt_pk_bf16(sv[0], sv[1]); spk[ts].y = cvt_pk_bf16(sv[2], sv[3]); rs += (sv[0] + sv[1]) + (sv[2] + sv[3]); } \
        rs = sum_x32(sum_x16(rs)); \
        { const float den = __expf(mt - Mcol) * nqp + rs; const float inv = __builtin_amdgcn_rcpf(fmaxf(fabsf(den), __expf(-(bcol + Mcol)))); if (lg == 0) scr[lr] = inv; } \
        const f32x4 inv4 = *(const LAS f32x4*)(scr + 4 * lg); \
        bf16x8 sf0, sf1; { u32x4 t0 = {spk[0].x, spk[0].y, spk[1].x, spk[1].y}, t1 = {spk[2].x, spk[2].y, spk[3].x, spk[3].y}; sf0 = __builtin_bit_cast(bf16x8, t0); sf1 = __builtin_bit_cast(bf16x8, t1); } \
        _Pragma("unroll") for (int i = 0; i < 2; ++i) { const int tdv = 2 * th + i; f32x4 acc = acc3[i]; \
            acc = __builtin_amdgcn_mfma_f32_16x16x32_bf16(sf0, vp[i][0], acc, 0, 0, 0); \
            acc = __builtin_amdgcn_mfma_f32_16x16x32_bf16(sf1, vp[i][1], acc, 0, 0, 0); \
            _Pragma("unroll") for (int r = 0; r < 4; ++r) { const long p = MS_POS(j, 16 * tl + 4 * lg + r); hout[p * DM + 16 * tdv + lr] = acc[r] * inv4[r]; } } \
        MS_SB(); \
        bf16x8 vf[4][2], ak[2]; \
        _Pragma("unroll") for (int c = 0; c < 4; ++c) _Pragma("unroll") for (int ks = 0; ks < 2; ++ks) vf[c][ks] = trfrag(Vi, c, ks, lane); \
        ak[0] = trfrag(Kw, w, 0, lane); ak[1] = trfrag(Kw, w, 1, lane); \
        MS_SB(); \
        _Pragma("unroll") for (int c = 0; c < 4; ++c) { f32x4 acc = Cacc[c] * gs; \
            acc = __builtin_amdgcn_mfma_f32_16x16x32_bf16(ak[0], vf[c][0], acc, 0, 0, 0); \
            acc = __builtin_amdgcn_mfma_f32_16x16x32_bf16(ak[1], vf[c][1], acc, 0, 0, 0); \
            Cacc[c] = acc; \
            u32x2 pk; pk.x = cvt_pk_bf16(acc[0], acc[1]); pk.y = cvt_pk_bf16(acc[2], acc[3]); \
            const int dk0 = 16 * w + 4 * lg; *(LAS u32x2*)(Cbw + offb(16 * c + lr, dk0 >> 3) + 2 * (dk0 & 7)) = pk; } \
        { f32x4 na = nacc * gs; na = __builtin_amdgcn_mfma_f32_16x16x32_bf16(ak[0], ones, na, 0, 0, 0); na = __builtin_amdgcn_mfma_f32_16x16x32_bf16(ak[1], ones, na, 0, 0, 0); nacc = na; \
          if (lr == 0) *(LAS f32x4*)(nvw + 16 * w + 4 * lg) = na; } } while (0)
    MS_LOAD(0, A); MS_STAGE(0, 0, A);
    __syncthreads();
    for (int j = 0; j < nch; ++j) {
        if (j + 1 < nch) MS_LOAD(j + 1, A);
        MS_CHUNK(j);
        if (j + 1 < nch) MS_STAGE(j + 1, (j + 1) & 1, A);
        __syncthreads();
    }
#undef MS_POS
#undef MS_LOAD
#undef MS_STAGE
#undef MS_CHUNK
#undef MS_SB
}
}

namespace ms3 {
using ms::offb; using ms::rowfrag; using ms::trfrag; using ms2::trfrag_perm; using ms2::bperm; using ms2::logsig;
constexpr int IMG = 16384, L_QS = 0, L_KW = 2 * IMG, L_V = 4 * IMG, L_CB = 6 * IMG;
constexpr int L_NB = LDS_XL, L_TAB = LDS_XL + 1024, L_SCR = LDS_XL + 2048;
__device__ __forceinline__ void scan_item(const bf16_t* __restrict__ hq, const bf16_t* __restrict__ hk, const bf16_t* __restrict__ hv, const float* __restrict__ gi, const float* __restrict__ gf,
                                          bf16_t* __restrict__ hout, int S, int dir, LAS unsigned char* L) {
    const int tid = opaque_tid(), lane = tid & 63, w = __builtin_amdgcn_readfirstlane(tid >> 6);
    const int nch = S >> 6, lr = lane & 15, lg = lane >> 4;
    LAS float* bLt = (LAS float*)(L + L_TAB); LAS float* pmLt = bLt + 64; LAS float* mtab = bLt + 128; LAS float* scr = (LAS float*)(L + L_SCR) + w * 16;
#define MS_POS(j, row) (dir ? (S - 1 - ((j) * 64 + (row))) : ((j) * 64 + (row)))
    { const u32x4 zz = {0u, 0u, 0u, 0u}; *(LAS u32x4*)(L + L_CB + tid * 32) = zz; *(LAS u32x4*)(L + L_CB + tid * 32 + 16) = zz; if (tid < 64) ((LAS unsigned*)(L + L_NB))[tid] = 0u; }
    bf16x8 rqA[2], rkA[2], rvA, rqB[2], rkB[2], rvB; float rgiA, rgfA, rgiB, rgfB;
#define MS_TOFF(p, cc) (((p) >> 4) * (long)((ML_MAIN >> 5) * 512) + ((p) & 15) * 32 + ((cc) >> 5) * 512 + ((cc) & 31))
#define MS_LOAD(j, X) do { _Pragma("unroll") for (int i_ = 0; i_ < 2; ++i_) { const int pi_ = tid + 512 * i_; const long p_ = MS_POS(j, pi_ >> 4); \
            const long o_ = MS_TOFF(p_, (pi_ & 15) * 8); rq##X[i_] = *(const bf16x8*)(hq + o_); rk##X[i_] = *(const bf16x8*)(hk + o_); } \
        { const long p_ = MS_POS(j, tid >> 3); rv##X = *(const bf16x8*)(hv + MS_TOFF(p_, (tid & 7) * 8)); } \
        { const long p_ = MS_POS(j, lane); rgi##X = gi[p_]; rgf##X = gf[p_]; } } while (0)
    MS_LOAD(0, A);
    { float pli[8], plf[8];
#pragma unroll
      for (int i = 0; i < 8; ++i) { const int c = w + 8 * i; if (c < nch) { const long p = MS_POS(c, lane); pli[i] = gi[p]; plf[i] = gf[p]; } else { pli[i] = 0.f; plf[i] = 0.f; } }
#pragma unroll
      for (int i = 0; i < 8; ++i) { const int c = w + 8 * i; if (c < nch) { const float lf = logsig(plf[i]); const float b = scan_add(lf), pm = scan_max(pli[i] - b); if (lane == 63) { bLt[c] = b; pmLt[c] = pm; } } } }
    __syncthreads();
    if (tid == 0) { float m = 0.f; for (int c = 0; c < nch; ++c) { mtab[c] = m; m = bLt[c] + fmaxf(m, pmLt[c]); } }
    __syncthreads();
    f32x4 Cacc[2][4], nacc[2];
#pragma unroll
    for (int t = 0; t < 2; ++t) { nacc[t] = (f32x4){0.f, 0.f, 0.f, 0.f};
#pragma unroll
        for (int i = 0; i < 4; ++i) Cacc[t][i] = (f32x4){0.f, 0.f, 0.f, 0.f}; }
    const bf16x8 ones = {0x3F80, 0x3F80, 0x3F80, 0x3F80, 0x3F80, 0x3F80, 0x3F80, 0x3F80};
    float va, vb, vpm;
#define MS_STAGE(j, bf, X) do { { const float lf_ = logsig(rgf##X); vb = scan_add(lf_); va = rgi##X - vb; vpm = scan_max(va); } \
        const float M63_ = fmaxf(mtab[j], __int_as_float(__builtin_amdgcn_readlane(__float_as_int(vpm), 63))); const float wsl_ = __expf(va - M63_); \
        _Pragma("unroll") for (int i_ = 0; i_ < 2; ++i_) { const int pi_ = tid + 512 * i_, row_ = pi_ >> 4, ch_ = pi_ & 15; const unsigned o_ = offb(row_, ch_); \
            *(LAS bf16x8*)(L + L_QS + (bf) * IMG + o_) = rq##X[i_]; const float ws_ = bperm(wsl_, row_) * 0.088388347648318440f; u32x4 k1_; \
            float kf_[8]; _Pragma("unroll") for (int e_ = 0; e_ < 8; ++e_) kf_[e_] = bf2f((unsigned short)rk##X[i_][e_]) * ws_; \
            k1_.x = cvt_pk_bf16(kf_[0], kf_[1]); k1_.y = cvt_pk_bf16(kf_[2], kf_[3]); k1_.z = cvt_pk_bf16(kf_[4], kf_[5]); k1_.w = cvt_pk_bf16(kf_[6], kf_[7]); \
            *(LAS u32x4*)(L + L_KW + (bf) * IMG + o_) = k1_; } \
        *(LAS bf16x8*)(L + L_V + (bf) * IMG + offb(tid >> 3, tid & 7)) = rv##X; } while (0)
#define MS_SB() __builtin_amdgcn_sched_barrier(0)
    MS_STAGE(0, 0, A); MS_LOAD(1, A);
    __syncthreads();
    auto chunk = [&](const int j) __attribute__((always_inline)) {
        const int cur = j & 1, nxt = cur ^ 1;
        LAS const unsigned char* Qs = L + L_QS + cur * IMG; LAS const unsigned char* Kw = L + L_KW + cur * IMG; LAS const unsigned char* Vi = L + L_V + cur * IMG;
        LAS const unsigned char* Cbr = L + L_CB + cur * IMG; LAS unsigned char* Cbw = L + L_CB + nxt * IMG;
        LAS const unsigned char* nbr = L + L_NB + cur * 256; LAS unsigned char* nbw = L + L_NB + nxt * 256;
        const float mt = mtab[j]; const float Mv = fmaxf(mt, vpm); const float M63 = __int_as_float(__builtin_amdgcn_readlane(__float_as_int(Mv), 63));
        if (w < 4) {
            const int tl = w, l = 16 * tl + lr;
            const float Mcol = bperm(Mv, l), bcol = bperm(vb, l);
            bf16x8 qf[4], kwa[2][4], nbv[4];
#pragma unroll
            for (int kk = 0; kk < 4; ++kk) qf[kk] = rowfrag(Qs, l, kk, lane);
#pragma unroll
            for (int t = 0; t < 2; ++t)
#pragma unroll
                for (int kk = 0; kk < 4; ++kk) kwa[t][kk] = rowfrag(Kw, 16 * t + lr, kk, lane);
#pragma unroll
            for (int kk = 0; kk < 4; ++kk) nbv[kk] = *(const LAS bf16x8*)(nbr + (32 * kk + 8 * lg) * 2);
            MS_SB();
            const float colscale = __expf(M63 - Mcol), gcol = __expf(mt - Mcol);
            f32x4 sacc[4];
#pragma unroll
            for (int t = 0; t < 2; ++t) { f32x4 acc = {0.f, 0.f, 0.f, 0.f};
#pragma unroll
                for (int kk = 0; kk < 4; ++kk) acc = __builtin_amdgcn_mfma_f32_16x16x32_bf16(kwa[t][kk], qf[kk], acc, 0, 0, 0);
                sacc[t] = acc; }
            MS_SB();
            bf16x8 kwb[2][4], cbf[2][4];
#pragma unroll
            for (int t = 0; t < 2; ++t)
#pragma unroll
                for (int kk = 0; kk < 4; ++kk) { kwb[t][kk] = rowfrag(Kw, 32 + 16 * t + lr, kk, lane); cbf[t][kk] = rowfrag(Cbr, 16 * t + lr, kk, lane); }
            MS_SB();
            float nqp = 0.f;
#pragma unroll
            for (int kk = 0; kk < 4; ++kk)
#pragma unroll
                for (int e = 0; e < 8; ++e) nqp += bf2f((unsigned short)qf[kk][e]) * bf2f((unsigned short)nbv[kk][e]);
            nqp = sum_x32(sum_x16(nqp));
#pragma unroll
            for (int t = 0; t < 2; ++t) { f32x4 acc = {0.f, 0.f, 0.f, 0.f};
#pragma unroll
                for (int kk = 0; kk < 4; ++kk) acc = __builtin_amdgcn_mfma_f32_16x16x32_bf16(kwb[t][kk], qf[kk], acc, 0, 0, 0);
                sacc[2 + t] = acc; }
            f32x4 acc3[4];
#pragma unroll
            for (int t = 0; t < 2; ++t) { f32x4 acc = {0.f, 0.f, 0.f, 0.f};
#pragma unroll
                for (int kk = 0; kk < 4; ++kk) acc = __builtin_amdgcn_mfma_f32_16x16x32_bf16(cbf[t][kk], qf[kk], acc, 0, 0, 0);
                acc3[t] = acc * gcol; }
            MS_SB();
            bf16x8 cbg[2][4], vp[2][2];
#pragma unroll
            for (int t = 0; t < 2; ++t) {
#pragma unroll
                for (int kk = 0; kk < 4; ++kk) cbg[t][kk] = rowfrag(Cbr, 32 + 16 * t + lr, kk, lane);
#pragma unroll
                for (int ks = 0; ks < 2; ++ks) vp[t][ks] = trfrag_perm(Vi, t, ks, lane); }
            MS_SB();
            u32x2 spk[4]; float rs = 0.f;
#pragma unroll
            for (int ts = 0; ts < 4; ++ts) { f32x4 sv;
#pragma unroll
                for (int r = 0; r < 4; ++r) { const int s = 16 * ts + 4 * lg + r; sv[r] = (s <= l) ? sacc[ts][r] * colscale : 0.f; }
                spk[ts].x = cvt_pk_bf16(sv[0], sv[1]); spk[ts].y = cvt_pk_bf16(sv[2], sv[3]); rs += (sv[0] + sv[1]) + (sv[2] + sv[3]); }
            rs = sum_x32(sum_x16(rs));
            const float inv = __builtin_amdgcn_rcpf(fmaxf(fabsf(gcol * nqp + rs), __expf(-(bcol + Mcol))));
            bf16_t* const hrow = hout + (long)MS_POS(j, l) * DM + ((lg & 1) ? 16 + 4 * (lg - 1) : 4 * lg);
#define MS_HSTORE(p, pe, po) do { const auto rx_ = __builtin_amdgcn_permlane16_swap((pe).x, (po).x, false, false); const auto ry_ = __builtin_amdgcn_permlane16_swap((pe).y, (po).y, false, false); \
                const u32x4 w_ = {rx_[0], ry_[0], rx_[1], ry_[1]}; *(u32x4*)(hrow + 32 * (p)) = w_; } while (0)
            u32x2 hpk[2];
            bf16x8 sf0, sf1; { u32x4 t0 = {spk[0].x, spk[0].y, spk[1].x, spk[1].y}, t1 = {spk[2].x, spk[2].y, spk[3].x, spk[3].y}; sf0 = __builtin_bit_cast(bf16x8, t0); sf1 = __builtin_bit_cast(bf16x8, t1); }
#pragma unroll
            for (int t = 0; t < 2; ++t) { f32x4 acc = {0.f, 0.f, 0.f, 0.f};
#pragma unroll
                for (int kk = 0; kk < 4; ++kk) acc = __builtin_amdgcn_mfma_f32_16x16x32_bf16(cbg[t][kk], qf[kk], acc, 0, 0, 0);
                acc3[2 + t] = acc * gcol; }
#pragma unroll
            for (int t = 0; t < 2; ++t) { f32x4 acc = acc3[t];
                acc = __builtin_amdgcn_mfma_f32_16x16x32_bf16(vp[t][0], sf0, acc, 0, 0, 0);
                acc = __builtin_amdgcn_mfma_f32_16x16x32_bf16(vp[t][1], sf1, acc, 0, 0, 0);
                { const f32x4 hv4 = acc * inv; hpk[t].x = cvt_pk_bf16(hv4[0], hv4[1]); hpk[t].y = cvt_pk_bf16(hv4[2], hv4[3]); } }
            MS_HSTORE(0, hpk[0], hpk[1]);
            MS_SB();
            bf16x8 vq[2][2];
#pragma unroll
            for (int t = 0; t < 2; ++t)
#pragma unroll
                for (int ks = 0; ks < 2; ++ks) vq[t][ks] = trfrag_perm(Vi, 2 + t, ks, lane);
            MS_SB();
#pragma unroll
            for (int t = 0; t < 2; ++t) { f32x4 acc = acc3[2 + t];
                acc = __builtin_amdgcn_mfma_f32_16x16x32_bf16(vq[t][0], sf0, acc, 0, 0, 0);
                acc = __builtin_amdgcn_mfma_f32_16x16x32_bf16(vq[t][1], sf1, acc, 0, 0, 0);
                { const f32x4 hv4 = acc * inv; hpk[t].x = cvt_pk_bf16(hv4[0], hv4[1]); hpk[t].y = cvt_pk_bf16(hv4[2], hv4[3]); } }
            MS_HSTORE(1, hpk[0], hpk[1]);
#undef MS_HSTORE
        } else {
            const float gs = __expf(mt - M63);
            bf16x8 vf[4][2], ak[2][2];
#pragma unroll
            for (int c = 0; c < 4; ++c)
#pragma unroll
                for (int ks = 0; ks < 2; ++ks) vf[c][ks] = trfrag(Vi, c, ks, lane);
#pragma unroll
            for (int t = 0; t < 2; ++t)
#pragma unroll
                for (int ks = 0; ks < 2; ++ks) ak[t][ks] = trfrag(Kw, 2 * (w - 4) + t, ks, lane);
            MS_SB();
#pragma unroll
            for (int t = 0; t < 2; ++t) { const int dkt = 2 * (w - 4) + t;
#pragma unroll
                for (int c = 0; c < 4; ++c) { f32x4 acc = Cacc[t][c] * gs;
                    acc = __builtin_amdgcn_mfma_f32_16x16x32_bf16(ak[t][0], vf[c][0], acc, 0, 0, 0);
                    acc = __builtin_amdgcn_mfma_f32_16x16x32_bf16(ak[t][1], vf[c][1], acc, 0, 0, 0);
                    Cacc[t][c] = acc;
                    u32x2 pk; pk.x = cvt_pk_bf16(acc[0], acc[1]); pk.y = cvt_pk_bf16(acc[2], acc[3]);
                    const int dk0 = 16 * dkt + 4 * lg; *(LAS u32x2*)(Cbw + offb(16 * c + lr, dk0 >> 3) + 2 * (dk0 & 7)) = pk; }
                f32x4 na = nacc[t] * gs; na = __builtin_amdgcn_mfma_f32_16x16x32_bf16(ak[t][0], ones, na, 0, 0, 0); na = __builtin_amdgcn_mfma_f32_16x16x32_bf16(ak[t][1], ones, na, 0, 0, 0); nacc[t] = na;
                if (lr == 0) { u32x2 pn; pn.x = cvt_pk_bf16(na[0], na[1]); pn.y = cvt_pk_bf16(na[2], na[3]); *(LAS u32x2*)(nbw + (16 * dkt + 4 * lg) * 2) = pn; } }
        }
    };
#define MS_LOOP() for (int j = 0; j < nch; j += 2) {   \
        if (j + 2 < nch) MS_LOAD(j + 2, B); \
        chunk(j); \
        MS_STAGE(j + 1, 1, A); \
        __syncthreads(); \
        if (j + 3 < nch) MS_LOAD(j + 3, A); \
        chunk(j + 1); \
        if (j + 2 < nch) MS_STAGE(j + 2, 0, B); \
        __syncthreads(); }
    if (w < 4) { MS_LOOP() } else { MS_LOOP() }
#undef MS_LOOP
#undef MS_POS
#undef MS_LOAD
#undef MS_TOFF
#undef MS_STAGE
#undef MS_SB
}
}

__global__ void __launch_bounds__(NTHR, 2) fwd(Args args) {
    extern __shared__ __attribute__((aligned(16))) unsigned char lds[];
    LAS unsigned char* L = (LAS unsigned char*)lds;
    typedef const __attribute__((address_space(4))) Args* KArgs;
    const KArgs apk = (KArgs)__builtin_amdgcn_kernarg_segment_ptr();
    const int lo = apk->ph_lo, hi = apk->ph_hi;
    volatile LAS unsigned* MISC = (volatile LAS unsigned*)(L + LDS_MISC);
    if (threadIdx.x < 64) MISC[threadIdx.x] = 0u;
    __syncthreads();
    XcdBarrier bar = xcd_barrier_post((unsigned*)(apk->ws + WS_CTL), MISC + 8);
#ifdef DBG_ONLY
#define RUN(p, tag) ((tag) == DBG_ONLY && lo <= (p) && (p) < hi)
#else
#define RUN(p, tag) (lo <= (p) && (p) < hi)
#endif
#define SEAM(p) do { if ((p) + 1 < hi) xcd_barrier(bar); } while (0)
#define REP(bit) for (int rep_ = 0; rep_ < (((PROBE_MASK >> (bit)) & 1) ? 2 : 1); ++rep_)
#define PH_ENTER() KArgs ap = apk; asm volatile("" : "+s"(ap)); unsigned char* const ws = ap->ws; (void)ws; const int tid = opaque_tid(), lane = tid & 63; (void)lane; \
    const int wave = __builtin_amdgcn_readfirstlane(tid >> 6); (void)wave; int G = gridDim.x; asm volatile("" : "+s"(G)); const int bx = blockIdx.x; \
    const int vcu = (G % 8 == 0) ? (bx % 8) * (G / 8) + bx / 8 : bx; (void)vcu;     \
    const int gw = vcu * NWAVES + wave, NGW = G * NWAVES; (void)gw; (void)NGW
#define IN(k) (ap->in[k])
#define Zf ((float*)ap->out)
#define ZB ((bf16_t*)(ws + WS_ZB))
#define RSv ((f32x2*)(ws + WS_RS))
#define Pv ((f32x2*)(ws + WS_P))
#define RSID ((const f32x2*)(ws + WS_RSID))
#define ZERO ((const float*)(ws + WS_ZERO))
#define ONE ((const float*)(ws + WS_ONE))
#define C1 ((const float*)(ws + WS_C1))
#define C2 ((const float*)(ws + WS_C2))
#define GATES ((float*)(ws + WS_GATES))
#define LNG(i) (IN(IN_LNG) + (i) * DM)
#define LNB(i) (IN(IN_LNB) + (i) * DM)

    if (RUN(0, 100)) {
        PH_ENTER();
        const size_t gtid = (size_t)vcu * NTHR + tid, gthreads = (size_t)G * NTHR;
        LAS float* scr = (LAS float*)(L + wave * 8704);
        int base = 0;
        for (int j = 0; j < N_TJOBS; ++j) {
            TJob J; make_tjob(j, ap, J);
            const int nitems = J.nat ? (J.K / 64) * (J.N / 128) : (J.K / 64) * (J.N / 32);
            int start = (gw - base) % NGW; if (start < 0) start += NGW;
            if (J.nat) { for (int it = start; it < nitems; it += NGW) convert_item(J, it, lane); }
            else { for (int it = start; it < nitems; it += NGW) transpose_item(J, scr, it, lane); }
            base = (base + nitems) % NGW;
        }
        cvt_rows(IN(IN_MEMP), (bf16_t*)(ws + S_MEMB), (size_t)2048 * DM / 8, gtid, gthreads);
        cvt_rows(IN(IN_MEMS), (bf16_t*)(ws + S_MEMB) + (size_t)2048 * DM, (size_t)1024 * DM / 8, gtid, gthreads);
        cvt_rows_tiled(IN(IN_XP), ZB, (size_t)NPR * DM / 8, gtid, gthreads);
        cvt_rows_tiled(IN(IN_XS), ZB + (size_t)NPR * DM, (size_t)NPR * DM / 8, gtid, gthreads);
        for (size_t i = gtid; i < 8192; i += gthreads) ((float*)(ws + WS_ZERO))[i] = 0.f;
        for (size_t i = gtid; i < 2048; i += gthreads) ((float*)(ws + WS_ONE))[i] = 1.f;
        if (gtid == 0) *(f32x2*)(ws + WS_RSID) = (f32x2){0.f, 1.f};
        if (bx == 0 && tid < 32) {
            double f = 1.0; for (int i = 0; i < tid; ++i) f *= 0.7498942093324558;
            double x2 = f * f, cs = 1.0, sn = f, tc = 1.0, ts = f;
            for (int k = 1; k <= 12; ++k) { tc *= -x2 / (double)((2 * k - 1) * (2 * k)); ts *= -x2 / (double)((2 * k) * (2 * k + 1)); cs += tc; sn += ts; }
            double c = 1.0, s = 0.0; f32x2* tab = (f32x2*)(ws + WS_ROPE);
            for (int p = 0; p < 64; ++p) { tab[p * 32 + tid] = (f32x2){(float)c, (float)s}; const double c2 = c * cs - s * sn, s2 = s * cs + c * sn; c = c2; s = s2; }
        }
        SEAM(0);
    }
    if (RUN(1, 101)) {
        { PH_ENTER();
          const size_t gtid = (size_t)vcu * NTHR + tid, gthreads = (size_t)G * NTHR;
          const f32x2* cp = (const f32x2*)(ws + S_CPART);
          for (int q = 0; q < 11; ++q) {
              int cv, N;
              if (q == 0) { cv = CV_ATT_IN; N = ATT_IN; } else if (q < 3) { cv = CV_ML_IN + (q - 1) * ML_IN; N = ML_IN; } else if (q < 7) { cv = CV_XAQ + (q - 3) * DM; N = DM; } else { cv = CV_W1 + (q - 7) * DFF; N = DFF; }
              const f32x2* src = cp + (size_t)cv * 32;
              for (size_t n = gtid; n < (size_t)N; n += gthreads) { float a = 0.f, b = 0.f;
                  for (int kb = 0; kb < 32; ++kb) { const f32x2 v = src[(size_t)kb * N + n]; a += v.x; b += v.y; }
                  ((float*)(ws + WS_C1))[cv + n] = a; ((float*)(ws + WS_C2))[cv + n] = b; } } }
        { PH_ENTER();
          pg8::Gemm g{DM, DM, DM}; pg8::PlainOrder S; S.init(MEMROWS, 4 * DM, G, bx, ws + S_MEMB, DM, ws + S_WKT, DM);
          pg8::EpiIn E{(bf16_t*)(ws + WS_KMEM), 4 * DM, RSID, 0, ZERO, ZERO, 0};
          pg8::gemm_phase<pg8::EpiIn, pg8::PlainOrder, PG_ALIGN, PG_SP2>(L, g, S, E); }
        { PH_ENTER();
          pg8::Gemm g{DM, DM, DM}; pg8::PlainOrder S; S.init(MEMROWS, 4 * DM, G, G - 1 - bx, ws + S_MEMB, DM, ws + S_WVT, DM);
          pg8::EpiIn E{(bf16_t*)(ws + WS_VT), 4 * DM, RSID, 0, ZERO, ZERO, 0};
          pg8::gemm_phase<pg8::EpiIn, pg8::PlainOrder, PG_ALIGN, PG_SP2>(L, g, S, E); }
        SEAM(1);
    }

    for (int Ly = 0; Ly < 4; ++Ly) {
        const int pb = PH_LAYER0 + Ly * SLOTS;
        if ((Ly & 1) == 0) {
            if (RUN(pb + 0, 0)) {
            REP(0) {
                PH_ENTER(); const int jj = Ly >> 1; const bool first = (Ly == 0);
                pg8::Gemm g{DM, DM, DM}; pg8::PlainOrder S; S.init(NTOK, ATT_IN, G, bx, ZB, DM, ws + W_ATT_IN + (size_t)jj * 12 * MiB, DM);
                pg8::EpiQKV E{(bf16_t*)(ws + S_QKV), first ? RSID : RSv, first ? 0 : 1, first ? ZERO : C1 + CV_ATT_IN, first ? ZERO : C2 + CV_ATT_IN,
                              IN(IN_QGAIN) + jj * 128, IN(IN_KGAIN) + jj * 128, (const f32x2*)(ws + WS_ROPE), (LAS float*)(L + LDS_XL)};
                pg8::gemm_phase<pg8::EpiQKV, pg8::PlainOrder, true, PG_SP2, true>(L, g, S, E);
            }
                SEAM(pb + 0);
            }
            if (RUN(pb + 2, 2)) {
            REP(1) {
                PH_ENTER(); bf16_t* qkv = (bf16_t*)(ws + S_QKV); bf16_t* ob = (bf16_t*)(ws + S_OB);
                const int per = 1024 / G > 0 ? 1024 / G : 1;
                for (int half = 0; half < 2; ++half)
                    for (int u = vcu * per; u < 1024 && u < (vcu + 1) * per; ++u) {
                        int b, kvh, gq, qb, row0, brow, seq;
                        if (half == 0) { qb = u & 7; gq = (u >> 3) & 3; kvh = (u >> 5) & 3; b = u >> 7; brow = b * 2048; row0 = brow + qb * 256; seq = 2048; }
                        else { qb = u & 15; gq = (u >> 4) & 3; kvh = (u >> 6) & 3; b = u >> 8; brow = NPR + b * 4096; row0 = brow + qb * 256; seq = 4096; }
                        const int head = kvh * 4 + gq;
                        att::attn_dense_body(qkv + (size_t)row0 * ATT_IN + head * 128, qkv + (size_t)brow * ATT_IN + 2048 + kvh * 128, qkv + (size_t)brow * ATT_IN + 2560 + kvh * 128,
                                             ob, row0, head * 128, seq, (char*)lds);
                    }
            }
                SEAM(pb + 2);
            }
        } else {
            for (int grp = 0; grp < 2; ++grp) {
                if (RUN(pb + 3 * grp + 0, 20)) {
            REP(0) {
                    { PH_ENTER(); const int jj = Ly >> 1, r0 = grp * NPR, cvo = CV_ML_IN + jj * ML_IN;
                      pg8::Gemm g{DM, DM, DM}; pg8::PlainOrder S; S.init(NPR, ML_MAIN, G, bx, ZB + (size_t)r0 * DM, DM, ws + W_ML_IN + (size_t)jj * 25 * MiB, DM);
                      pg8::EpiInT E{(bf16_t*)(ws + S_H), ML_MAIN, RSv + r0, 1, C1 + cvo, C2 + cvo, 0};
                      pg8::gemm_phase<pg8::EpiInT, pg8::PlainOrder, PG_ALIGN, PG_SP2, true>(L, g, S, E); }
                    { PH_ENTER(); const int jj = Ly >> 1, r0 = grp * NPR, cvo = CV_ML_IN + jj * ML_IN;
                      const bf16_t* WgT = (const bf16_t*)(ws + W_ML_IN + (size_t)jj * 25 * MiB) + (size_t)ML_MAIN * DM;
                      const float* bg = IN(IN_ML_BGATE) + jj * 32; const bf16_t* zb = ZB; float* gates = GATES;
                      for (int it = gw; it < (grp == 0 ? NTOK / 16 : 0); it += NGW) {
                          const int rr = it * 16;
                          const bf16_t* Ap = zb + tile_off(rr + (lane & 15), 8 * (lane >> 4), DM);
                          const bf16_t* B0 = WgT + (size_t)(lane & 15) * DM + 8 * (lane >> 4); const bf16_t* B1 = B0 + (size_t)16 * DM;
                          f32x4 a0 = {0.f, 0.f, 0.f, 0.f}, a1 = {0.f, 0.f, 0.f, 0.f};
#pragma unroll 16
                          for (int kk = 0; kk < 64; ++kk) { const bf16x8 av = *(const bf16x8*)(Ap + kk * 512), b0 = *(const bf16x8*)(B0 + kk * 32), b1 = *(const bf16x8*)(B1 + kk * 32);
                              a0 = __builtin_amdgcn_mfma_f32_16x16x32_bf16(b0, av, a0, 0, 0, 0); a1 = __builtin_amdgcn_mfma_f32_16x16x32_bf16(b1, av, a1, 0, 0, 0); }
                          const int row = rr + (lane & 15); const f32x2 st = RSv[row];
#pragma unroll
                          for (int r = 0; r < 4; ++r) { const int n0 = 4 * (lane >> 4) + r, n1 = n0 + 16;
                              const float c10 = C1[cvo + ML_MAIN + n0], c20 = C2[cvo + ML_MAIN + n0] + bg[n0], c11 = C1[cvo + ML_MAIN + n1], c21 = C2[cvo + ML_MAIN + n1] + bg[n1];
                              gates[(size_t)n0 * NTOK + row] = (a0[r] - st.x * c10) * st.y + c20; gates[(size_t)n1 * NTOK + row] = (a1[r] - st.x * c11) * st.y + c21; }
                      } }
            }
                    SEAM(pb + 3 * grp + 0);
                }
                if (RUN(pb + 3 * grp + 1, 21)) {
            REP(2) {
                    PH_ENTER(); const int r0 = grp * NPR; const bf16_t* hbuf = (const bf16_t*)(ws + S_H); bf16_t* hf = (bf16_t*)(ws + S_HF); bf16_t* hbk = (bf16_t*)(ws + S_HB); const float* gates = GATES;
                    const int nb = grp == 0 ? 8 : 4, S_len = grp == 0 ? 2048 : 4096; const int nitems = nb * 8 * 2 * 4;
                    for (int it = vcu; it < nitems; it += G) {
                        const int sl = it & 3, dir = (it >> 2) & 1, hd = (it >> 3) & 7, b = it >> 6;
                        const size_t lrow = (size_t)b * S_len;
                        ms3::scan_item(hbuf + tile_off((int)lrow, hd * 128, ML_MAIN), hbuf + tile_off((int)lrow, 1024 + hd * 128, ML_MAIN), hbuf + tile_off((int)lrow, 2048 + hd * 256 + sl * 64, ML_MAIN),
                                  gates + (size_t)((dir * 2) * 8 + hd) * NTOK + r0 + lrow, gates + (size_t)((dir * 2 + 1) * 8 + hd) * NTOK + r0 + lrow,
                                  (dir ? hbk : hf) + lrow * DM + hd * 256 + sl * 64, S_len, dir, L);
                    }
            }
                    SEAM(pb + 3 * grp + 1);
                }
                if (RUN(pb + 3 * grp + 2, 22)) {
            REP(3) {
                    PH_ENTER(); const int jj = Ly >> 1, r0 = grp * NPR; const bf16_t* hbuf = (const bf16_t*)(ws + S_H); const bf16_t* hf = (const bf16_t*)(ws + S_HF); const bf16_t* hbk = (const bf16_t*)(ws + S_HB);
                    bf16_t* hsb = (bf16_t*)(ws + S_HSB);
                    const float* hg = IN(IN_ML_HGAIN) + jj * 2048;
                    for (int it0 = gw * 2; it0 < (NPR / 2) * 8; it0 += NGW * 2) {
                        u32x4 fa[2], fb[2], ow[2];
#pragma unroll
                        for (int q = 0; q < 2; ++q) { const int it = it0 + q, lrow = 2 * (it >> 3) + (lane >> 5), hd = it & 7, col = hd * 256 + (lane & 31) * 8;
                            fa[q] = *(const u32x4*)(hf + (size_t)lrow * DM + col); fb[q] = *(const u32x4*)(hbk + (size_t)lrow * DM + col);
                            ow[q] = *(const u32x4*)(hbuf + tile_off(lrow, 4096 + col, ML_MAIN)); }
#pragma unroll
                        for (int q = 0; q < 2; ++q) { const int it = it0 + q, lrow = 2 * (it >> 3) + (lane >> 5), hd = it & 7, col = hd * 256 + (lane & 31) * 8;
                            const u32x4 a = fa[q], b = fb[q], og = ow[q];
                            const f32x4 s0 = {bf2f(a.x & 0xffffu) + bf2f(b.x & 0xffffu), bf2f(a.x >> 16) + bf2f(b.x >> 16), bf2f(a.y & 0xffffu) + bf2f(b.y & 0xffffu), bf2f(a.y >> 16) + bf2f(b.y >> 16)};
                            const f32x4 s1 = {bf2f(a.z & 0xffffu) + bf2f(b.z & 0xffffu), bf2f(a.z >> 16) + bf2f(b.z >> 16), bf2f(a.w & 0xffffu) + bf2f(b.w & 0xffffu), bf2f(a.w >> 16) + bf2f(b.w >> 16)};
                            const f32x4 q0 = s0 * s0 + s1 * s1; float ssq = (q0[0] + q0[1]) + (q0[2] + q0[3]);
                            ssq += DPPF(0.f, ssq, 0xB1, 0xf); ssq += DPPF(0.f, ssq, 0x4E, 0xf); ssq += DPPF(0.f, ssq, 0x141, 0xf); ssq += DPPF(0.f, ssq, 0x140, 0xf); ssq = sum_x16(ssq);
                            const float rn = 1.0f / sqrtf(ssq * (1.f / 256.f) + RMS_EPS);
                            const f32x4 g0 = *(const f32x4*)(hg + col), g1 = *(const f32x4*)(hg + col + 4);
                            const f32x4 o0 = {bf2f(og.x & 0xffffu), bf2f(og.x >> 16), bf2f(og.y & 0xffffu), bf2f(og.y >> 16)}, o1 = {bf2f(og.z & 0xffffu), bf2f(og.z >> 16), bf2f(og.w & 0xffffu), bf2f(og.w >> 16)};
                            f32x4 y0, y1;
#pragma unroll
                            for (int e = 0; e < 4; ++e) { y0[e] = s0[e] * rn * g0[e] * __builtin_amdgcn_rcpf(1.f + __expf(-o0[e])); y1[e] = s1[e] * rn * g1[e] * __builtin_amdgcn_rcpf(1.f + __expf(-o1[e])); }
                            u32x4 w; w.x = cvt_pk_bf16(y0[0], y0[1]); w.y = cvt_pk_bf16(y0[2], y0[3]); w.z = cvt_pk_bf16(y1[0], y1[1]); w.w = cvt_pk_bf16(y1[2], y1[3]);
                            *(u32x4*)(hsb + tile_off(r0 + lrow, col, DM)) = w; }
                    }
            }
                    SEAM(pb + 3 * grp + 2);
                }
            }
        }
        if (RUN(pb + 6, 6)) {
            PH_ENTER(); const int jj = Ly >> 1; const bool first = (Ly == 0), isatt = (Ly & 1) == 0;
            const void* mix_out = isatt ? (const void*)(ws + S_OB) : (const void*)(ws + S_HSB);
            const void* w_out = isatt ? (const void*)(ws + W_ATT_OUT + (size_t)jj * 8 * MiB) : (const void*)(ws + W_ML_OUT + (size_t)jj * 8 * MiB);
            pg8::Gemm g{DM, DM, DM}; pg8::PlainOrder S; S.init(NTOK, DM, G, bx, mix_out, DM, w_out, DM);
            const int li = first ? 0 : (Ly - 1) * 3 + 2;
            pg8::EpiRes E{ZB, first ? RSID : RSv, first ? 0 : 1, first ? ONE : LNG(li), first ? ZERO : LNB(li), Pv};
            pg8::gemm_phase<pg8::EpiRes, pg8::PlainOrder, PG_ALIGN, PG_SP2, true>(L, g, S, E);
            SEAM(pb + 6);
        }
#define STATS_PHASE(ph) if (RUN(ph, 7)) { PH_ENTER(); const f32x2* P_ = Pv; f32x2* RS_ = RSv; \
            for (int it = gw; it < NTOK / 16; it += NGW) { const int row = it * 16 + (lane & 15), g_ = lane >> 4;     \
                float s = 0.f, q = 0.f; \
                _Pragma("unroll") for (int l_ = 0; l_ < 8; ++l_) { const f32x2 v = P_[(size_t)(g_ * 8 + l_) * NTOK + row]; s += v.x; q += v.y; } \
                s = sum_x32(sum_x16(s)); q = sum_x32(sum_x16(q)); \
                const float mean = s * (1.f / DM); const float var = q * (1.f / DM) - mean * mean; \
                if (lane < 16) RS_[row] = (f32x2){mean, 1.0f / sqrtf(var + LN_EPS)}; } \
            SEAM(ph); }
        if (RUN(pb + 7, 8)) {
            REP(0) {
            { PH_ENTER();
              struct MkOrder { int G, c, Ly; const char* km; const char* wq;
                  __device__ __forceinline__ bool next(int i, pg8::Unit& u) const { const int Lx = i * G + c; if (Lx >= 384) return false; u.pm = Lx >> 3; u.pn = Lx & 7;
                      u.a = km + ((size_t)(u.pm >> 2) * 256 * 8192 + Ly * 2048 + (u.pm & 3) * 512) * 2; u.b = wq + ((size_t)u.pn * 256 * DM + (u.pm & 3) * 512) * 2; return true; } };
              MkOrder S{G, vcu, Ly, (const char*)(ws + WS_KMEM), (const char*)(ws + W_XA_Q + (size_t)Ly * 8 * MiB)};
              int Km = 512; asm volatile("" : "+s"(Km)); pg8::Gemm g{4 * DM, DM, Km}; pg8::EpiIn E{(bf16_t*)(ws + S_QX), DM, RSID, 0, ZERO, ZERO, 0};
              pg8::gemm_phase<pg8::EpiIn, MkOrder, PG_ALIGN, PG_SP2>(L, g, S, E); }
            { PH_ENTER();
            struct VwOrder { int G, c, Ly; const char* wo; const char* vn;
                __device__ __forceinline__ bool next(int i, pg8::Unit& u) const { const int Lx = i * G + c; if (Lx >= 384) return false; u.pm = Lx >> 2; u.pn = Lx & 3;
                    u.a = wo + ((size_t)(u.pm & 7) * 256 * DM + u.pn * 512) * 2; u.b = vn + ((size_t)(u.pm >> 3) * 256 * 8192 + Ly * 2048 + u.pn * 512) * 2; return true; } };
            VwOrder S2{G, G - 1 - vcu, Ly, (const char*)(ws + W_XA_OUT + (size_t)Ly * 8 * MiB), (const char*)(ws + WS_VT)};
            int Kv = 512; asm volatile("" : "+s"(Kv)); pg8::Gemm g2{DM, 4 * DM, Kv}; pg8::EpiIn E2{(bf16_t*)(ws + S_OX), 1024, RSID, 0, ZERO, ZERO, 0};
            pg8::gemm_phase<pg8::EpiIn, VwOrder, PG_ALIGN, PG_SP2>(L, g2, S2, E2);
            }
            { PH_ENTER();
              const bf16_t* km = (const bf16_t*)(ws + WS_KMEM); const float* c1q = C1 + CV_XAQ + Ly * DM; const float* c2q = C2 + CV_XAQ + Ly * DM;
              float* c1s = (float*)(ws + WS_C1S); float* c2s = (float*)(ws + WS_C2S);
              for (int it = gw; it < 48 * 256; it += NGW) { const int mbh = it >> 8, m = it & 255, mb = mbh >> 2, h = mbh & 3;
                  const u32x4 kw = *(const u32x4*)(km + (size_t)(mb * 256 + m) * 8192 + Ly * 2048 + h * 512 + lane * 8);
                  const f32x4 a0 = *(const f32x4*)(c1q + h * 512 + lane * 8), a1 = *(const f32x4*)(c1q + h * 512 + lane * 8 + 4), b0 = *(const f32x4*)(c2q + h * 512 + lane * 8), b1 = *(const f32x4*)(c2q + h * 512 + lane * 8 + 4);
                  const f32x4 k0 = {bf2f(kw.x & 0xffffu), bf2f(kw.x >> 16), bf2f(kw.y & 0xffffu), bf2f(kw.y >> 16)}, k1 = {bf2f(kw.z & 0xffffu), bf2f(kw.z >> 16), bf2f(kw.w & 0xffffu), bf2f(kw.w >> 16)};
                  const f32x4 p1 = k0 * a0 + k1 * a1, p2 = k0 * b0 + k1 * b1;
                  const float s1 = wave_sum((p1[0] + p1[1]) + (p1[2] + p1[3])), s2 = wave_sum((p2[0] + p2[1]) + (p2[2] + p2[3]));
                  if (lane == 0) { c1s[it] = s1; c2s[it] = s2; } } }
            }
        }
        STATS_PHASE(pb + 7)
        if (RUN(pb + 9, 9)) {
            REP(0) {
            PH_ENTER();
            struct ScoreOrder { int G, c; const char* zb; const char* mk;
                __device__ __forceinline__ bool next(int i, pg8::Unit& u) const { const int Lx = i * G + c; if (Lx >= 512) return false; u.pm = Lx >> 2; u.pn = Lx & 3;
                    const int mb = u.pm < 64 ? (u.pm >> 3) : 8 + ((u.pm - 64) >> 4);
                    u.a = zb + (size_t)u.pm * 256 * DM * 2; u.b = mk + (size_t)(mb * 4 + u.pn) * 256 * DM * 2; return true; } };
            ScoreOrder S{G, vcu, (const char*)ZB, (const char*)(ws + S_QX)};
            pg8::Gemm g{DM, DM, DM}; pg8::EpiSoftmax E{(bf16_t*)(ws + S_PB), 1024, 0.04419417382415922f, (LAS float*)(L + LDS_XL), RSv, (const float*)(ws + WS_C1S), (const float*)(ws + WS_C2S)};
            pg8::gemm_phase<pg8::EpiSoftmax, ScoreOrder, true, PG_SP2, true>(L, g, S, E);
            }
            SEAM(pb + 9);
        }
        if (RUN(pb + 12, 12)) {
            PH_ENTER();
            struct XoOrder { int G, c; const char* pb_; const char* vw;
                __device__ __forceinline__ bool next(int i, pg8::Unit& u) const { const int Lx = i * G + c; if (Lx >= 1024) return false; u.pm = Lx >> 3; u.pn = Lx & 7;
                    const int mb = u.pm < 64 ? (u.pm >> 3) : 8 + ((u.pm - 64) >> 4);
                    u.a = pb_ + (size_t)u.pm * 256 * 1024 * 2; u.b = vw + ((size_t)(mb * 2048 + u.pn * 256) * 1024) * 2; return true; } };
            XoOrder S{G, vcu, (const char*)(ws + S_PB), (const char*)(ws + S_OX)};
            int Kx = 1024; asm volatile("" : "+s"(Kx)); pg8::Gemm g{1024, 1024, Kx};
            pg8::EpiRes E{ZB, RSv, 1, LNG(Ly * 3 + 0), LNB(Ly * 3 + 0), Pv};
            pg8::gemm_phase<pg8::EpiRes, XoOrder, PG_ALIGN, PG_SP2, true>(L, g, S, E);
            SEAM(pb + 12);
        }
        STATS_PHASE(pb + 13)
        for (int mg = 0; mg < MLP_NB; ++mg) {
        if (RUN(pb + 14 + 2 * mg, 14)) {
            REP(0) {
            PH_ENTER(); const int r0 = mg * (NTOK / MLP_NB);
            pg8::Gemm g{DM, DM, DM}; pg8::PlainOrder S; S.init(NTOK / MLP_NB, DFF, G, bx, ZB + (size_t)r0 * DM, DM, ws + W_W1 + (size_t)Ly * 32 * MiB, DM);
            pg8::EpiInT E{(bf16_t*)(ws + S_HID), DFF, RSv + r0, 1, C1 + CV_W1 + Ly * DFF, C2 + CV_W1 + Ly * DFF, 1};
            pg8::gemm_phase<pg8::EpiInT, pg8::PlainOrder, PG_ALIGN, PG_SP2, true>(L, g, S, E);
            }
            SEAM(pb + 14 + 2 * mg);
        }
        if (RUN(pb + 15 + 2 * mg, 15)) {
            PH_ENTER(); const int r0 = mg * (NTOK / MLP_NB);
            pg8::Gemm g{DFF, DFF, DFF}; pg8::PlainOrder S; S.init(NTOK / MLP_NB, DM, G, bx, ws + S_HID, DFF, ws + W_W2 + (size_t)Ly * 32 * MiB, DFF); S.rev = 1;
            pg8::EpiRes E{ZB + (size_t)r0 * DM, RSv + r0, 1, LNG(Ly * 3 + 1), LNB(Ly * 3 + 1), Pv + r0};
            pg8::gemm_phase<pg8::EpiRes, pg8::PlainOrder, PG_ALIGN, PG_SP2, true>(L, g, S, E);
            SEAM(pb + 15 + 2 * mg);
        }
        }
        STATS_PHASE(pb + 14 + 2 * MLP_NB)
    }
    if (RUN(PH_FINAL, 102)) {
        PH_ENTER(); float* z = Zf; const bf16_t* zb = ZB; const f32x2* RS_ = RSv;
        const float* gq = LNG(3 * 3 + 2); const float* bq = LNB(3 * 3 + 2);
        u32x4 zn[4]; f32x2 stn = RS_[gw];
#pragma unroll
        for (int j = 0; j < 4; ++j) zn[j] = *(const u32x4*)(zb + tile_off(gw, j * 512 + lane * 8, DM));
        for (int row = gw; row < NTOK; row += NGW) { const f32x2 st = stn; float* zr = z + (size_t)row * DM; u32x4 zc[4];
#pragma unroll
            for (int j = 0; j < 4; ++j) zc[j] = zn[j];
            if (row + NGW < NTOK) { stn = RS_[row + NGW];
#pragma unroll
                for (int j = 0; j < 4; ++j) zn[j] = *(const u32x4*)(zb + tile_off(row + NGW, j * 512 + lane * 8, DM)); }
#pragma unroll
            for (int j = 0; j < 4; ++j) { const int c = j * 512 + lane * 8; const u32x4 zw = zc[j];
                const f32x4 v0 = {bf2f(zw.x & 0xffffu), bf2f(zw.x >> 16), bf2f(zw.y & 0xffffu), bf2f(zw.y >> 16)}, v1 = {bf2f(zw.z & 0xffffu), bf2f(zw.z >> 16), bf2f(zw.w & 0xffffu), bf2f(zw.w >> 16)};
                const f32x4 g0 = *(const f32x4*)(gq + c), g1 = *(const f32x4*)(gq + c + 4), b0 = *(const f32x4*)(bq + c), b1 = *(const f32x4*)(bq + c + 4);
                *(f32x4*)(zr + c) = (v0 - st.x) * st.y * g0 + b0; *(f32x4*)(zr + c + 4) = (v1 - st.x) * st.y * g1 + b1; } }
    }
#undef RUN
#undef SEAM
#undef STATS_PHASE
}

static bool phase_used(int ph) {
    if (ph < PH_LAYER0 || ph >= PH_FINAL) return true;
    const int Ly = (ph - PH_LAYER0) / SLOTS, s = (ph - PH_LAYER0) % SLOTS;
    if ((Ly & 1) == 0 && ((s >= 3 && s <= 5) || s == 1)) return false;
    if (s == 8 || s == 10 || s == 11) return false;
    return true;
}
extern "C" void kernel_launch(void* const* d_in, const int* in_sizes, int n_in, void* d_out, int out_size, void* d_ws, size_t ws_size, hipStream_t stream) {
    static int grid = 0;
    if (grid == 0) {
        if (n_in != 19 || out_size != NTOK * DM || ws_size < WS_END) { fprintf(stderr, "kernel_launch: unexpected shapes: n_in %d out %d ws %zu (need %zu)\n", n_in, out_size, ws_size, (size_t)WS_END); grid = -1; return; }
        int dev = 0, cus = 0;
        if (hipGetDevice(&dev) != hipSuccess || hipDeviceGetAttribute(&cus, hipDeviceAttributeMultiprocessorCount, dev) != hipSuccess) { grid = -1; return; }
        if (hipFuncSetAttribute((const void*)fwd, hipFuncAttributeMaxDynamicSharedMemorySize, LDS_BYTES) != hipSuccess) { fprintf(stderr, "kernel_launch: hipFuncSetAttribute failed\n"); grid = -1; return; }
        int per_cu = 0;
        if (hipOccupancyMaxActiveBlocksPerMultiprocessor(&per_cu, (const void*)fwd, NTHR, LDS_BYTES) != hipSuccess || per_cu < 1) fprintf(stderr, "kernel_launch: occupancy query reports %d\n", per_cu);
        (void)hipGetLastError();
        grid = cus;
        if (grid != 256) fprintf(stderr, "kernel_launch: %d CUs (tuned for 256)\n", grid);
    }
    if (grid < 0) return;
    (void)hipMemsetAsync((char*)d_ws + WS_CTL, 0, CTL_ZERO_BYTES, stream);
    Args a{};
    for (int i = 0; i < 19; ++i) a.in[i] = (const float*)d_in[i];
    a.out = (float*)d_out; a.ws = (unsigned char*)d_ws;
#if MK_ONE_LAUNCH
    a.ph_lo = 0; a.ph_hi = PH_END;
    hipLaunchKernelGGL(fwd, dim3(grid), dim3(NTHR), LDS_BYTES, stream, a);
#else
    for (int ph = 0; ph < PH_END; ++ph) { if (!phase_used(ph)) continue; a.ph_lo = ph; a.ph_hi = ph + 1; hipLaunchKernelGGL(fwd, dim3(grid), dim3(NTHR), LDS_BYTES, stream, a); }
#endif
    const hipError_t le = hipPeekAtLastError();
    if (le != hipSuccess) fprintf(stderr, "kernel_launch: launch failed: %s\n", hipGetErrorName(le));
}
```
